# Optimizing an MI355X kernel written in HIP

```python
import jax, jax.numpy as jnp
from jax import lax
import numpy as np

D_MODEL = 2048
BATCH = 1
SEQ = 8192
DEPTH = 4

N_MIXERS = 2
N_ATTN = (DEPTH + 1) // 2
N_REC = DEPTH // 2
HEAD_DIM = 64
N_Q_HEADS = D_MODEL // HEAD_DIM
N_KV_HEADS = 8
GROUP = N_Q_HEADS // N_KV_HEADS
WINDOW = 128
BLOCK = 128
QKV_DIM = (N_Q_HEADS + 2 * N_KV_HEADS) * HEAD_DIM
LRU_WIDTH = D_MODEL
LRU_BLOCKS = 8
LRU_BLOCK_DIM = LRU_WIDTH // LRU_BLOCKS
LRU_CONV = 4
LRU_C = 8.0
D_FF = 3 * D_MODEL
FFN_CONV = 3
EPS = 1e-6

kernel_name = "hybrid_swa_sink_rglru_convffn"


def rmsnorm(x, g):
    xf = x.astype(jnp.float32)
    y = xf * lax.rsqrt(jnp.mean(xf * xf, axis=-1, keepdims=True) + EPS)
    return (y * g.astype(jnp.float32)).astype(x.dtype)


def causal_dwconv(x, w, b):
    K = w.shape[0]
    T = x.shape[1]
    xp = jnp.pad(x, ((0, 0), (K - 1, 0), (0, 0)))
    y = b
    for k in range(K):
        y = y + xp[:, k:k + T] * w[k]
    return y


def sliding_window_attention(h, w_qkv, q_gain, k_gain, sinks, w_o):
    B, T, _ = h.shape
    nb = T // BLOCK
    qkv = h @ w_qkv
    q, k, v = jnp.split(qkv, [N_Q_HEADS * HEAD_DIM, (N_Q_HEADS + N_KV_HEADS) * HEAD_DIM], axis=-1)
    q = rmsnorm(q.reshape(B, T, N_KV_HEADS, GROUP, HEAD_DIM), q_gain)
    k = rmsnorm(k.reshape(B, T, N_KV_HEADS, HEAD_DIM), k_gain)
    v = v.reshape(B, T, N_KV_HEADS, HEAD_DIM)
    q = q.reshape(B, nb, BLOCK, N_KV_HEADS, GROUP, HEAD_DIM)
    kb = k.reshape(B, nb, BLOCK, N_KV_HEADS, HEAD_DIM)
    vb = v.reshape(B, nb, BLOCK, N_KV_HEADS, HEAD_DIM)
    pad = ((0, 0), (1, 0), (0, 0), (0, 0), (0, 0))
    kw = jnp.concatenate([jnp.pad(kb, pad)[:, :-1], kb], axis=2)
    vw = jnp.concatenate([jnp.pad(vb, pad)[:, :-1], vb], axis=2)
    scores = jnp.einsum('bnqhgd,bnkhd->bnhgqk', q, kw).astype(jnp.float32) * (HEAD_DIM ** -0.5)
    qpos = jnp.arange(BLOCK)[:, None] + BLOCK
    kpos = jnp.arange(2 * BLOCK)[None, :]
    rel = qpos - kpos
    band = (rel >= 0) & (rel < WINDOW)
    real_key = (jnp.arange(nb)[:, None] > 0) | (jnp.arange(2 * BLOCK)[None, :] >= BLOCK)
    mask = band[None, :, :] & real_key[:, None, :]
    scores = jnp.where(mask[None, :, None, None], scores, jnp.finfo(jnp.float32).min)
    sink = jnp.broadcast_to(sinks.astype(jnp.float32).reshape(1, 1, N_KV_HEADS, GROUP, 1, 1),
                            scores.shape[:-1] + (1,))
    probs = jax.nn.softmax(jnp.concatenate([scores, sink], axis=-1), axis=-1)[..., :-1]
    out = jnp.einsum('bnhgqk,bnkhd->bnqhgd', probs.astype(vw.dtype), vw)
    return out.reshape(B, T, N_Q_HEADS * HEAD_DIM) @ w_o


def rglru_block(h, w_in, conv_w, conv_b, w_a, b_a, w_i, b_i, lam, w_out):
    B, T, _ = h.shape
    xb, yb = jnp.split(h @ w_in, 2, axis=-1)
    gate = jax.nn.gelu(yb, approximate=True)
    xb = causal_dwconv(xb, conv_w, conv_b)
    xh = xb.reshape(B, T, LRU_BLOCKS, LRU_BLOCK_DIM)
    r = jax.nn.sigmoid(jnp.einsum('bthi,hij->bthj', xh, w_a) + b_a).reshape(B, T, LRU_WIDTH)
    i = jax.nn.sigmoid(jnp.einsum('bthi,hij->bthj', xh, w_i) + b_i).reshape(B, T, LRU_WIDTH)
    log_a = -LRU_C * r.astype(jnp.float32) * jax.nn.softplus(-lam.astype(jnp.float32))
    a = jnp.exp(log_a)
    u = jnp.sqrt(-jnp.expm1(2.0 * log_a)) * (i * xb).astype(jnp.float32)

    def combine(left, right):
        a1, b1 = left
        a2, b2 = right
        return a1 * a2, a2 * b1 + b2

    _, hs = lax.associative_scan(combine, (a, u), axis=1)
    return (hs.astype(h.dtype) * gate) @ w_out


def conv_ffn(h, w_up, conv_w, conv_b, w_down):
    u = causal_dwconv(h @ w_up, conv_w, conv_b)
    g, v = jnp.split(u, 2, axis=-1)
    return (jax.nn.gelu(g, approximate=True) * v) @ w_down


def setup_inputs(seed: int = 0) -> dict:
    key = jax.random.key(seed)
    ks = iter(jax.random.split(key, 32))
    f32 = jnp.float32

    def nrm(shape, scale):
        return jax.random.normal(next(ks), shape, f32) * scale

    def gain(shape):
        return 1.0 + 0.02 * jax.random.normal(next(ks), shape, f32)

    a0 = jax.random.uniform(next(ks), (N_REC, LRU_WIDTH), f32, 0.9, 0.999)
    return {
        "x": jax.random.normal(next(ks), (BATCH, SEQ, D_MODEL), f32),
        "mix_norm": gain((DEPTH, D_MODEL)),
        "ffn_norm": gain((DEPTH, D_MODEL)),
        "attn_w_qkv": nrm((N_ATTN, D_MODEL, QKV_DIM), D_MODEL ** -0.5),
        "attn_q_gain": gain((N_ATTN, HEAD_DIM)),
        "attn_k_gain": gain((N_ATTN, HEAD_DIM)),
        "attn_sinks": nrm((N_ATTN, N_Q_HEADS), 0.5),
        "attn_w_o": nrm((N_ATTN, N_Q_HEADS * HEAD_DIM, D_MODEL), (N_Q_HEADS * HEAD_DIM) ** -0.5),
        "rec_w_in": nrm((N_REC, D_MODEL, 2 * LRU_WIDTH), D_MODEL ** -0.5),
        "rec_conv_w": nrm((N_REC, LRU_CONV, LRU_WIDTH), LRU_CONV ** -0.5),
        "rec_conv_b": nrm((N_REC, LRU_WIDTH), 0.01),
        "rec_w_a": nrm((N_REC, LRU_BLOCKS, LRU_BLOCK_DIM, LRU_BLOCK_DIM), LRU_BLOCK_DIM ** -0.5),
        "rec_b_a": nrm((N_REC, LRU_BLOCKS, LRU_BLOCK_DIM), 0.01),
        "rec_w_i": nrm((N_REC, LRU_BLOCKS, LRU_BLOCK_DIM, LRU_BLOCK_DIM), LRU_BLOCK_DIM ** -0.5),
        "rec_b_i": nrm((N_REC, LRU_BLOCKS, LRU_BLOCK_DIM), 0.01),
        "rec_lambda": jnp.log(a0) - jnp.log1p(-a0),
        "rec_w_out": nrm((N_REC, LRU_WIDTH, D_MODEL), LRU_WIDTH ** -0.5),
        "ffn_w_up": nrm((DEPTH, D_MODEL, 2 * D_FF), D_MODEL ** -0.5),
        "ffn_conv_w": nrm((DEPTH, FFN_CONV, 2 * D_FF), FFN_CONV ** -0.5),
        "ffn_conv_b": nrm((DEPTH, 2 * D_FF), 0.01),
        "ffn_w_down": nrm((DEPTH, D_FF, D_MODEL), D_FF ** -0.5),
    }


def reference(x, mix_norm, ffn_norm, attn_w_qkv, attn_q_gain, attn_k_gain, attn_sinks, attn_w_o,
              rec_w_in, rec_conv_w, rec_conv_b, rec_w_a, rec_b_a, rec_w_i, rec_b_i, rec_lambda,
              rec_w_out, ffn_w_up, ffn_conv_w, ffn_conv_b, ffn_w_down):
    for layer in range(DEPTH):
        h = rmsnorm(x, mix_norm[layer])
        j = layer // N_MIXERS
        if layer % N_MIXERS == 0:
            x = x + sliding_window_attention(h, attn_w_qkv[j], attn_q_gain[j], attn_k_gain[j],
                                             attn_sinks[j], attn_w_o[j])
        else:
            x = x + rglru_block(h, rec_w_in[j], rec_conv_w[j], rec_conv_b[j], rec_w_a[j], rec_b_a[j],
                                rec_w_i[j], rec_b_i[j], rec_lambda[j], rec_w_out[j])
        h = rmsnorm(x, ffn_norm[layer])
        x = x + conv_ffn(h, ffn_w_up[layer], ffn_conv_w[layer], ffn_conv_b[layer], ffn_w_down[layer])
    return x
```

```cpp
#include <hip/hip_runtime.h>
#include <hip/hip_cooperative_groups.h>
#include <cstdio>
#include <cstdint>
namespace cg = cooperative_groups;

#define LAS __attribute__((address_space(3)))
typedef unsigned short bf16_t;
typedef short bf16x8 __attribute__((ext_vector_type(8)));
typedef float f32x4 __attribute__((ext_vector_type(4)));
typedef float f32x2 __attribute__((ext_vector_type(2)));
typedef float f32x16 __attribute__((ext_vector_type(16)));
typedef unsigned u32x4 __attribute__((ext_vector_type(4)));
typedef unsigned u32x2 __attribute__((ext_vector_type(2)));

constexpr int T = 8192, D = 2048, QKVD = 3072, FF = 6144, FF2 = 12288;
constexpr float EPS = 1e-6f;
constexpr float LOG2E = 1.4426950408889634f;
constexpr float SSQ_SCALE = 4294967296.0f, SSQ_INV = 1.0f / 4294967296.0f;

constexpr size_t MiB = 1u << 20;
constexpr size_t WS_SSQ = 0;
constexpr size_t WS_BAR = 1 * MiB;
constexpr size_t WS_CARRY = 2 * MiB;
constexpr size_t WS_WQKV = 16 * MiB, WS_WO = 40 * MiB, WS_WIN = 56 * MiB, WS_WG = 88 * MiB, WS_WOUT = 92 * MiB, WS_WUP = 108 * MiB, WS_WDN = 300 * MiB;
constexpr size_t WS_XB = 400 * MiB, WS_QKV = 432 * MiB, WS_AO = 480 * MiB, WS_REC = 512 * MiB, WS_XC = 576 * MiB, WS_GA = 608 * MiB, WS_GU = 672 * MiB,
                 WS_HG = 736 * MiB, WS_P = 768 * MiB, WS_ACT = 960 * MiB, WS_END = 1056 * MiB;

constexpr int LDS_BYTES = 147456, MISC_OFF = 147200, NSTEPS = 32;
#ifndef DEFER_CONV
#define DEFER_CONV 1
#endif

__device__ __forceinline__ unsigned cvt_pk_bf16(float lo, float hi) { unsigned r; asm volatile("v_cvt_pk_bf16_f32 %0, %1, %2" : "=v"(r) : "v"(lo), "v"(hi)); return r; }
__device__ __forceinline__ float bflo(unsigned w) { return __uint_as_float(w << 16); }
__device__ __forceinline__ float bfhi(unsigned w) { return __uint_as_float(w & 0xffff0000u); }
__device__ __forceinline__ float gelu_tanh(float x) {
    const float z = 0.7978845608028654f * (x + 0.044715f * x * x * x);
    return x * __builtin_amdgcn_rcpf(1.0f + __builtin_amdgcn_exp2f(-2.0f * LOG2E * z));
}
__device__ __forceinline__ f32x2 gelu_tanh2(f32x2 x) {
    const f32x2 w = (x * x) * 0.044715f + 1.0f;
    const f32x2 t = (x * w) * (-2.0f * LOG2E * 0.7978845608028654f);
    f32x2 e; e.x = __builtin_amdgcn_exp2f(t.x); e.y = __builtin_amdgcn_exp2f(t.y);
    const f32x2 d = e + 1.0f;
    f32x2 r; r.x = __builtin_amdgcn_rcpf(d.x); r.y = __builtin_amdgcn_rcpf(d.y);
    return x * r;
}
__device__ __forceinline__ float sigmoidf_(float v) { return __builtin_amdgcn_rcpf(1.0f + __builtin_amdgcn_exp2f(-LOG2E * v)); }

namespace pg8 {
constexpr int BM = 256, BK = 64, HALF = 128, HTB = HALF * BK * 2, STAGE_BYTES = 8 * HTB, NXCD = 8, WGM = 8;
__host__ __device__ __forceinline__ int lds_byte(int r, int c) { const int st = (r >> 4) * 2 + (c >> 5), rr = r & 15, cc = c & 31, ob = rr * 64 + cc * 2; return st * 1024 + (ob ^ (((ob >> 9) & 1) << 5)); }
__host__ __device__ __forceinline__ void stage_rc(int b, int& R, int& C) { const int st = b / 1024, sb = b % 1024, swz = sb ^ (((sb >> 9) & 1) << 5); R = (st >> 1) * 16 + swz / 64; C = (st & 1) * 32 + (swz % 64) / 2; }
__host__ __device__ __forceinline__ int perm32(int rho) { const int n = rho >> 4, i = rho & 15; return 8 * (i >> 2) + 4 * n + (i & 3); }

struct Unit { int pm, pn; };
struct Gemm { const bf16_t* A; const bf16_t* Bt; int M, N, K, lda, ldb, agrp; };

struct StaticOrder {
    int nM, nN, nwg, G, c;
    __host__ __device__ void init(int M, int N, int G_, int c_) { nM = M / BM; nN = N / BM; nwg = nM * nN; G = G_; c = c_; }
    __host__ __device__ bool next(int i, Unit& u) const {
        const long L = (long)i * G + c; if (L >= nwg) return false;
        int wgid = (int)L; { const int q = nwg / NXCD, r = nwg % NXCD, xcd = wgid % NXCD, off = wgid / NXCD; wgid = (xcd < r ? xcd * (q + 1) : r * (q + 1) + (xcd - r) * q) + off; }
        const int nig = WGM * nN, gid = wgid / nig, fm = gid * WGM, gsz = (nM - fm) < WGM ? (nM - fm) : WGM;
        u.pm = fm + ((wgid % nig) % gsz); u.pn = (wgid % nig) / gsz; return true;
    }
};


struct EpiScaleBf16 {
    bf16_t* O; int ldc; const unsigned long long* ssq;
    __device__ __forceinline__ void operator()(const f32x4 (&acc)[2][2][4][2], const Unit& u, int wr, int wc, int fr, int fq) const {
        const int row0 = u.pm * BM + wr * 64 + fr, col0 = u.pn * BM + wc * 32 + 8 * fq;
#pragma unroll
        for (int ai = 0; ai < 2; ++ai)
#pragma unroll
            for (int m = 0; m < 4; ++m) {
                const int row = row0 + ai * HALF + m * 16;
                const float rs = ssq ? rsqrtf((float)ssq[row] * SSQ_INV * (1.0f / D) + EPS) : 1.0f;
                bf16_t* rowp = O + (size_t)row * ldc + col0;
#pragma unroll
                for (int bj = 0; bj < 2; ++bj) { const f32x4 v0 = acc[ai][bj][m][0] * rs, v1 = acc[ai][bj][m][1] * rs;
                    u32x4 w; w.x = cvt_pk_bf16(v0[0], v0[1]); w.y = cvt_pk_bf16(v0[2], v0[3]); w.z = cvt_pk_bf16(v1[0], v1[1]); w.w = cvt_pk_bf16(v1[2], v1[3]);
                    *(u32x4*)(rowp + bj * HALF) = w; } }
    }
};
struct EpiResid {
    const float* xold_f32; float* xnew_f32; bf16_t* xb; unsigned long long* ssq;
    __device__ __forceinline__ void finish_row(const f32x4 (&o)[2][2], int row, size_t off, int fq) const {
        float s = 0.f;
#pragma unroll
        for (int bj = 0; bj < 2; ++bj) { const f32x4 o0 = o[bj][0], o1 = o[bj][1];
            if (xnew_f32) { *(f32x4*)(xnew_f32 + off + bj * HALF) = o0; *(f32x4*)(xnew_f32 + off + bj * HALF + 4) = o1; }
            else *(u32x4*)(xb + off + bj * HALF) = (u32x4){cvt_pk_bf16(o0[0], o0[1]), cvt_pk_bf16(o0[2], o0[3]), cvt_pk_bf16(o1[0], o1[1]), cvt_pk_bf16(o1[2], o1[3])};
            const f32x4 q = o0 * o0 + o1 * o1; s += (q[0] + q[1]) + (q[2] + q[3]); }
        if (ssq) { s += __shfl_xor(s, 16); s += __shfl_xor(s, 32);
            if (fq == 0) __hip_atomic_fetch_add(ssq + row, (unsigned long long)(s * SSQ_SCALE), __ATOMIC_RELAXED, __HIP_MEMORY_SCOPE_AGENT); }
    }
    __device__ __forceinline__ void operator()(const f32x4 (&acc)[2][2][4][2], const Unit& u, int wr, int wc, int fr, int fq) const {
        const int row0 = u.pm * BM + wr * 64 + fr, col0 = u.pn * BM + wc * 32 + 8 * fq;
        if (xold_f32) {
#pragma unroll
            for (int ai = 0; ai < 2; ++ai)
#pragma unroll
                for (int m = 0; m < 4; ++m) {
                    const int row = row0 + ai * HALF + m * 16; const size_t off = (size_t)row * D + col0;
                    f32x4 o[2][2];
#pragma unroll
                    for (int bj = 0; bj < 2; ++bj) { o[bj][0] = *(const f32x4*)(xold_f32 + off + bj * HALF) + acc[ai][bj][m][0]; o[bj][1] = *(const f32x4*)(xold_f32 + off + bj * HALF + 4) + acc[ai][bj][m][1]; }
                    finish_row(o, row, off, fq);
                }
            return;
        }
        u32x4 xr[2][4][2];
#pragma unroll
        for (int ai = 0; ai < 2; ++ai)
#pragma unroll
            for (int m = 0; m < 4; ++m)
#pragma unroll
                for (int bj = 0; bj < 2; ++bj) xr[ai][m][bj] = *(const u32x4*)(xb + (size_t)(row0 + ai * HALF + m * 16) * D + col0 + bj * HALF);
#pragma unroll
        for (int ai = 0; ai < 2; ++ai)
#pragma unroll
            for (int m = 0; m < 4; ++m) {
                const int row = row0 + ai * HALF + m * 16; const size_t off = (size_t)row * D + col0;
                f32x4 o[2][2];
#pragma unroll
                for (int bj = 0; bj < 2; ++bj) { const u32x4 x = xr[ai][m][bj];
                    o[bj][0] = (f32x4){bflo(x.x), bfhi(x.x), bflo(x.y), bfhi(x.y)} + acc[ai][bj][m][0]; o[bj][1] = (f32x4){bflo(x.z), bfhi(x.z), bflo(x.w), bfhi(x.w)} + acc[ai][bj][m][1]; }
                finish_row(o, row, off, fq);
            }
    }
};
template <int CTRL> __device__ __forceinline__ float dppf(float old, float src) {
    return __int_as_float(__builtin_amdgcn_update_dpp(__float_as_int(old), __float_as_int(src), CTRL, 0xf, 0xf, false));
}
template <int CTRL> __device__ __forceinline__ float dpp0(float src) {
    return __int_as_float(__builtin_amdgcn_update_dpp(0, __float_as_int(src), CTRL, 0xf, 0xf, true));
}
template <int S> __device__ __forceinline__ float rowprev(float cur, float pb) {
    const float o = dppf<0x100 + 16 - S>(0.f, pb);
    return dppf<0x110 + S>(o, cur);
}
struct EpiConvAct {
    bf16_t* ACT; const unsigned long long* ssq; const float* cw; const float* cb; float* halo; LAS unsigned char* hl;
    __device__ __forceinline__ void operator()(f32x4 (&acc)[2][2][4][2], const Unit& u, int wr, int wc, int fr, int fq) const {
        const int row0 = u.pm * BM + wr * 64 + fr, tcol = wc * 32 + 8 * fq;
#pragma unroll
        for (int ai = 0; ai < 2; ++ai)
#pragma unroll
            for (int m = 0; m < 4; ++m) {
                const float rs = rsqrtf((float)ssq[row0 + ai * HALF + m * 16] * SSQ_INV * (1.0f / D) + EPS);
#pragma unroll
                for (int bj = 0; bj < 2; ++bj)
#pragma unroll
                    for (int n = 0; n < 2; ++n) acc[ai][bj][m][n] = acc[ai][bj][m][n] * rs; }
        if (fr >= 14) {
#pragma unroll
            for (int ai = 0; ai < 2; ++ai)
#pragma unroll
                for (int bj = 0; bj < 2; ++bj)
#pragma unroll
                    for (int n = 0; n < 2; ++n) *(LAS f32x4*)(hl + ((((2 * ai + wr) * 2 + (fr - 14)) * 256) + bj * HALF + tcol + 4 * n) * 4) = acc[ai][bj][3][n];
            if (wr == 1) {
#pragma unroll
                for (int bj = 0; bj < 2; ++bj)
#pragma unroll
                    for (int n = 0; n < 2; ++n) *(f32x4*)(halo + (size_t)(u.pm * 4 + 2 + fr - 14) * FF2 + u.pn * BM + bj * HALF + tcol + 4 * n) = acc[1][bj][3][n]; }
        }
        if (wr == 0 && fr < 2) {
#pragma unroll
            for (int bj = 0; bj < 2; ++bj)
#pragma unroll
                for (int n = 0; n < 2; ++n) *(f32x4*)(halo + (size_t)(u.pm * 4 + fr) * FF2 + u.pn * BM + bj * HALF + tcol + 4 * n) = acc[0][bj][0][n]; }
        asm volatile("s_waitcnt lgkmcnt(0)" ::: "memory"); __builtin_amdgcn_s_barrier(); asm volatile("" ::: "memory");
        const int ch0 = u.pn * HALF + tcol;
        u32x2 pk[2][4][2];
#pragma unroll
        for (int n = 0; n < 2; ++n) {
            const float* cwp = cw + ch0 + 4 * n;
            const f32x4 wg0 = *(const f32x4*)(cwp), wg1 = *(const f32x4*)(cwp + FF2), wg2 = *(const f32x4*)(cwp + 2 * FF2), bg = *(const f32x4*)(cb + ch0 + 4 * n);
            const f32x4 wv0 = *(const f32x4*)(cwp + FF), wv1 = *(const f32x4*)(cwp + FF2 + FF), wv2 = *(const f32x4*)(cwp + 2 * FF2 + FF), bv = *(const f32x4*)(cb + FF + ch0 + 4 * n);
#pragma unroll
            for (int ai = 0; ai < 2; ++ai) {
                const int q = 2 * ai + wr;
                f32x4 pg = {0.f, 0.f, 0.f, 0.f}, pv = {0.f, 0.f, 0.f, 0.f};
                if (q > 0 && fr >= 14) { pg = *(const LAS f32x4*)(hl + ((((q - 1) * 2 + (fr - 14)) * 256) + tcol + 4 * n) * 4); pv = *(const LAS f32x4*)(hl + ((((q - 1) * 2 + (fr - 14)) * 256) + HALF + tcol + 4 * n) * 4); }
#pragma unroll
                for (int m = 0; m < 4; ++m) {
                    const f32x4 cg = acc[ai][0][m][n], cv = acc[ai][1][m][n];
                    const f32x4 gp = m > 0 ? acc[ai][0][m > 0 ? m - 1 : 0][n] : pg, vp = m > 0 ? acc[ai][1][m > 0 ? m - 1 : 0][n] : pv;
                    float ugv[4], uvv[4];
                    const f32x4 ug4 = wg2 * cg + bg, uv4 = wv2 * cv + bv;
#pragma unroll
                    for (int e = 0; e < 4; ++e) {
                        float ug = ug4[e], uv = uv4[e];
                        asm("v_fmac_f32_dpp %0, %1, %2 row_shr:1 row_mask:0xf bank_mask:0xf\n\tv_fmac_f32_dpp %0, %3, %2 row_shl:15 row_mask:0xf bank_mask:0xf" : "+v"(ug) : "v"(cg[e]), "v"(wg1[e]), "v"(gp[e]));
                        asm("v_fmac_f32_dpp %0, %1, %2 row_shr:2 row_mask:0xf bank_mask:0xf\n\tv_fmac_f32_dpp %0, %3, %2 row_shl:14 row_mask:0xf bank_mask:0xf" : "+v"(ug) : "v"(cg[e]), "v"(wg0[e]), "v"(gp[e]));
                        asm("v_fmac_f32_dpp %0, %1, %2 row_shr:1 row_mask:0xf bank_mask:0xf\n\tv_fmac_f32_dpp %0, %3, %2 row_shl:15 row_mask:0xf bank_mask:0xf" : "+v"(uv) : "v"(cv[e]), "v"(wv1[e]), "v"(vp[e]));
                        asm("v_fmac_f32_dpp %0, %1, %2 row_shr:2 row_mask:0xf bank_mask:0xf\n\tv_fmac_f32_dpp %0, %3, %2 row_shl:14 row_mask:0xf bank_mask:0xf" : "+v"(uv) : "v"(cv[e]), "v"(wv0[e]), "v"(vp[e]));
                        ugv[e] = ug; uvv[e] = uv; }
                    const f32x2 o01 = gelu_tanh2((f32x2){ugv[0], ugv[1]}) * (f32x2){uvv[0], uvv[1]}, o23 = gelu_tanh2((f32x2){ugv[2], ugv[3]}) * (f32x2){uvv[2], uvv[3]};

                    pk[ai][m][n] = (u32x2){cvt_pk_bf16(o01.x, o01.y), cvt_pk_bf16(o23.x, o23.y)};
                }
            }
        }
#pragma unroll
        for (int ai = 0; ai < 2; ++ai)
#pragma unroll
            for (int m = 0; m < 4; ++m)
                *(u32x4*)(ACT + (size_t)(row0 + ai * HALF + m * 16) * FF + ch0) = (u32x4){pk[ai][m][0].x, pk[ai][m][0].y, pk[ai][m][1].x, pk[ai][m][1].y};
    }
};
__device__ __forceinline__ float dpp_shr1_keep(float old, float src) { return __int_as_float(__builtin_amdgcn_update_dpp(__float_as_int(old), __float_as_int(src), 0x111, 0xf, 0xf, false)); }
__device__ __forceinline__ void conv3_rows(const f32x4& x0, const f32x4& x1, const f32x4& x2, const f32x4& x3, const f32x4& p2, const f32x4& p3,
                                           const f32x4& w0, const f32x4& w1, const f32x4& w2, const f32x4& b, f32x4 (&u)[4]) {
    f32x4 t3, t2;
#pragma unroll
    for (int e = 0; e < 4; ++e) { t3[e] = dpp_shr1_keep(p3[e], x3[e]); t2[e] = dpp_shr1_keep(p2[e], x2[e]); }
    u[0] = w2 * x0 + b; u[0] = w1 * t3 + u[0]; u[0] = w0 * t2 + u[0];
    u[1] = w2 * x1 + b; u[1] = w1 * x0 + u[1]; u[1] = w0 * t3 + u[1];
    u[2] = w2 * x2 + b; u[2] = w1 * x1 + u[2]; u[2] = w0 * x0 + u[2];
    u[3] = w2 * x3 + b; u[3] = w1 * x2 + u[3]; u[3] = w0 * x1 + u[3];
}
struct EpiConvActP {
    bf16_t* ACT; const unsigned long long* ssq; const float* cw; const float* cb; float* halo; LAS unsigned char* hl;
    __device__ __forceinline__ void operator()(f32x4 (&acc)[2][2][4][2], const Unit& u, int wr, int wc, int fr, int fq) const {
        const int rowb = u.pm * BM + wr * 64 + 4 * fr, tcol = wc * 32 + 8 * fq;
#pragma unroll
        for (int ai = 0; ai < 2; ++ai)
#pragma unroll
            for (int m = 0; m < 4; ++m) {
                const float rs = rsqrtf((float)ssq[rowb + ai * HALF + m] * SSQ_INV * (1.0f / D) + EPS);
#pragma unroll
                for (int bj = 0; bj < 2; ++bj)
#pragma unroll
                    for (int n = 0; n < 2; ++n) acc[ai][bj][m][n] = acc[ai][bj][m][n] * rs; }
        if (fr == 15) {
#pragma unroll
            for (int ai = 0; ai < 2; ++ai)
#pragma unroll
                for (int bj = 0; bj < 2; ++bj)
#pragma unroll
                    for (int n = 0; n < 2; ++n) { LAS unsigned char* hp = hl + ((((2 * ai + wr) * 2) * 256) + bj * HALF + tcol + 4 * n) * 4;
                        *(LAS f32x4*)(hp) = acc[ai][bj][2][n]; *(LAS f32x4*)(hp + 1024) = acc[ai][bj][3][n]; }
            if (wr == 1) {
#pragma unroll
                for (int bj = 0; bj < 2; ++bj)
#pragma unroll
                    for (int n = 0; n < 2; ++n) { float* gp = halo + (size_t)(u.pm * 4 + 2) * FF2 + u.pn * BM + bj * HALF + tcol + 4 * n;
                        *(f32x4*)(gp) = acc[1][bj][2][n]; *(f32x4*)(gp + FF2) = acc[1][bj][3][n]; } }
        }
        if (wr == 0 && fr == 0) {
#pragma unroll
            for (int bj = 0; bj < 2; ++bj)
#pragma unroll
                for (int n = 0; n < 2; ++n) { float* gp = halo + (size_t)(u.pm * 4) * FF2 + u.pn * BM + bj * HALF + tcol + 4 * n;
                    *(f32x4*)(gp) = acc[0][bj][0][n]; *(f32x4*)(gp + FF2) = acc[0][bj][1][n]; } }
        asm volatile("s_waitcnt lgkmcnt(0)" ::: "memory"); __builtin_amdgcn_s_barrier(); asm volatile("" ::: "memory");
        const int ch0 = u.pn * HALF + tcol;
        u32x2 pk[2][4][2];
#pragma unroll
        for (int n = 0; n < 2; ++n) {
            const float* cwp = cw + ch0 + 4 * n;
            const f32x4 wg0 = *(const f32x4*)(cwp), wg1 = *(const f32x4*)(cwp + FF2), wg2 = *(const f32x4*)(cwp + 2 * FF2), bg = *(const f32x4*)(cb + ch0 + 4 * n);
            const f32x4 wv0 = *(const f32x4*)(cwp + FF), wv1 = *(const f32x4*)(cwp + FF2 + FF), wv2 = *(const f32x4*)(cwp + 2 * FF2 + FF), bv = *(const f32x4*)(cb + FF + ch0 + 4 * n);
#pragma unroll
            for (int ai = 0; ai < 2; ++ai) {
                const int q = 2 * ai + wr;
                f32x4 pg2 = {0.f, 0.f, 0.f, 0.f}, pg3 = pg2, pv2 = pg2, pv3 = pg2;
                if (q > 0 && fr == 0) { const LAS unsigned char* hp = hl + ((((q - 1) * 2) * 256) + tcol + 4 * n) * 4;
                    pg2 = *(const LAS f32x4*)(hp); pg3 = *(const LAS f32x4*)(hp + 1024); pv2 = *(const LAS f32x4*)(hp + HALF * 4); pv3 = *(const LAS f32x4*)(hp + 1024 + HALF * 4); }
                f32x4 ug[4], uv[4];
                conv3_rows(acc[ai][0][0][n], acc[ai][0][1][n], acc[ai][0][2][n], acc[ai][0][3][n], pg2, pg3, wg0, wg1, wg2, bg, ug);
                conv3_rows(acc[ai][1][0][n], acc[ai][1][1][n], acc[ai][1][2][n], acc[ai][1][3][n], pv2, pv3, wv0, wv1, wv2, bv, uv);
#pragma unroll
                for (int m = 0; m < 4; ++m) {
                    const f32x2 o01 = gelu_tanh2((f32x2){ug[m][0], ug[m][1]}) * (f32x2){uv[m][0], uv[m][1]}, o23 = gelu_tanh2((f32x2){ug[m][2], ug[m][3]}) * (f32x2){uv[m][2], uv[m][3]};
                    pk[ai][m][n] = (u32x2){cvt_pk_bf16(o01.x, o01.y), cvt_pk_bf16(o23.x, o23.y)};
                }
            }
        }
#pragma unroll
        for (int ai = 0; ai < 2; ++ai)
#pragma unroll
            for (int m = 0; m < 4; ++m)
                *(u32x4*)(ACT + (size_t)(rowb + ai * HALF + m) * FF + ch0) = (u32x4){pk[ai][m][0].x, pk[ai][m][0].y, pk[ai][m][1].x, pk[ai][m][1].y};
    }
};
template <class Epi, bool ALIGN_EPI, bool APERM = false>
__device__ __forceinline__ void gemm_phase(LAS unsigned char* lds, const Gemm g, const StaticOrder& S, const Epi& E) {
    int tid = threadIdx.x; asm volatile("" : "+v"(tid));
    const int wid = __builtin_amdgcn_readfirstlane(tid >> 6), lane = tid & 63, wr = wid >> 2, wc = wid & 3, fr = lane & 15, fq = lane >> 4;
    const int nt = g.K / BK;
    unsigned voffA[2], voffB[2];
#pragma unroll
    for (int i = 0; i < 2; ++i) { int R, C; stage_rc(tid * 16 + i * 8192, R, C); const int Rb = (R & ~31) + perm32(R & 31);
        const int Ra = APERM ? ((R & 64) + 4 * (R & 15) + ((R >> 4) & 3)) : R;
        voffA[i] = (unsigned)(Ra * g.lda + C) * 2u; voffB[i] = (unsigned)(Rb * g.ldb + C) * 2u; }
    const size_t kstep = (size_t)(BK * 2);
    const size_t hstepA = (size_t)HALF * g.lda * 2, hstepB = (size_t)HALF * g.ldb * 2;
    const size_t tstepA = 2 * hstepA, tstepB = 2 * hstepB;
    const unsigned ldsw = (unsigned)wid * 1024u;
    const int aoff = lds_byte(wr * 64 + fr, fq * 8), boff = lds_byte(wc * 32 + fr, fq * 8);
#define PG8_SA(b, h) (((b) * 2 + (h)) * HTB)
#define PG8_SB(b, h) ((4 + (b) * 2 + (h)) * HTB)
#define PG8_STAGE(bufoff, gbase, voff) do { _Pragma("unroll") for (int _i = 0; _i < 2; ++_i) \
        __builtin_amdgcn_global_load_lds((const unsigned*)((const char*)(gbase) + (voff)[_i]), (LAS unsigned*)(lds + (bufoff) + ldsw + _i * 8192), 16, 0, 0); } while (0)
#define PG8_LDA(dst, b, h) do { _Pragma("unroll") for (int m = 0; m < 4; ++m) _Pragma("unroll") for (int k = 0; k < 2; ++k) dst[m][k] = *(const LAS bf16x8*)(lds + PG8_SA(b, h) + aoff + m * 2048 + k * 1024); } while (0)
#define PG8_LDB(dst, b, h) do { _Pragma("unroll") for (int n = 0; n < 2; ++n) _Pragma("unroll") for (int k = 0; k < 2; ++k) dst[n][k] = *(const LAS bf16x8*)(lds + PG8_SB(b, h) + boff + n * 2048 + k * 1024); } while (0)
#define PG8_MMA(ai, bj, At, Bt) do { __builtin_amdgcn_s_setprio(1); _Pragma("unroll") for (int m = 0; m < 4; ++m) _Pragma("unroll") for (int n = 0; n < 2; ++n) _Pragma("unroll") for (int k = 0; k < 2; ++k) \
        acc[ai][bj][m][n] = __builtin_amdgcn_mfma_f32_16x16x32_bf16(Bt[n][k], At[m][k], acc[ai][bj][m][n], 0, 0, 0); __builtin_amdgcn_s_setprio(0); } while (0)
#define PG8_WAIT_V(n) asm volatile("s_waitcnt vmcnt(" #n ")" ::: "memory")
#define PG8_WAIT_L(n) asm volatile("s_waitcnt lgkmcnt(" #n ")" ::: "memory")
#define PG8_BAR __builtin_amdgcn_s_barrier()
#define PG8_SCHED __builtin_amdgcn_sched_barrier(0)
    Unit cur, nxt; int ui = 0;
    if (!S.next(0, cur)) return;
    f32x4 acc[2][2][4][2];
#pragma unroll
    for (int a = 0; a < 2; ++a)
#pragma unroll
        for (int b = 0; b < 2; ++b)
#pragma unroll
            for (int m = 0; m < 4; ++m)
#pragma unroll
                for (int n = 0; n < 2; ++n) acc[a][b][m][n] = (f32x4){0.f, 0.f, 0.f, 0.f};
    bf16x8 At[4][2], B0[2][2], B1[2][2];
    const char* cA = (const char*)g.A + (size_t)cur.pm * tstepA + (size_t)(cur.pn >> 1) * g.agrp; const char* cB = (const char*)g.Bt + (size_t)cur.pn * tstepB;
    PG8_STAGE(PG8_SB(0, 0), cB, voffB); PG8_STAGE(PG8_SB(0, 1), cB + hstepB, voffB); PG8_STAGE(PG8_SA(0, 0), cA, voffA); PG8_STAGE(PG8_SA(0, 1), cA + hstepA, voffA);
    if (wr == 1) PG8_BAR;
    PG8_WAIT_V(2); PG8_BAR;
    PG8_STAGE(PG8_SB(1, 0), cB + kstep, voffB); PG8_STAGE(PG8_SA(1, 0), cA + kstep, voffA); PG8_STAGE(PG8_SB(1, 1), cB + hstepB + kstep, voffB);
    PG8_WAIT_V(6); PG8_BAR;
    for (;;) {
        const bool has_next = S.next(ui + 1, nxt);
        const char* nA = has_next ? (const char*)g.A + (size_t)nxt.pm * tstepA + (size_t)(nxt.pn >> 1) * g.agrp : cA; const char* nB = has_next ? (const char*)g.Bt + (size_t)nxt.pn * tstepB : cB;
        for (int t = 0; t < nt; t += 2) {
            const bool last = (t == nt - 2);
            const char* a1 = cA + (size_t)(t + 1) * kstep;
            const char* a2 = last ? nA : cA + (size_t)(t + 2) * kstep; const char* b2 = last ? nB : cB + (size_t)(t + 2) * kstep;
            const char* a3 = a2 + kstep; const char* b3 = b2 + kstep;
            PG8_LDB(B0, 0, 0); PG8_LDB(B1, 0, 1); PG8_SCHED; PG8_LDA(At, 0, 0); PG8_STAGE(PG8_SA(1, 1), a1 + hstepA, voffA);
            PG8_WAIT_V(8); PG8_WAIT_L(0); PG8_BAR; PG8_MMA(0, 0, At, B0); PG8_MMA(0, 1, At, B1); PG8_BAR; PG8_SCHED;
            PG8_LDA(At, 0, 1); PG8_STAGE(PG8_SB(0, 0), b2, voffB); PG8_STAGE(PG8_SB(0, 1), b2 + hstepB, voffB); PG8_STAGE(PG8_SA(0, 0), a2, voffA);
            PG8_WAIT_V(8); PG8_WAIT_L(0); PG8_BAR; PG8_MMA(1, 0, At, B0); PG8_MMA(1, 1, At, B1); PG8_BAR; PG8_SCHED;
            PG8_LDB(B0, 1, 0); PG8_LDB(B1, 1, 1); PG8_SCHED; PG8_LDA(At, 1, 0); PG8_STAGE(PG8_SA(0, 1), a2 + hstepA, voffA);
            PG8_WAIT_V(8); PG8_WAIT_L(0); PG8_BAR; PG8_MMA(0, 0, At, B0); PG8_MMA(0, 1, At, B1); PG8_BAR; PG8_SCHED;
            PG8_LDA(At, 1, 1); PG8_STAGE(PG8_SB(1, 0), b3, voffB); PG8_STAGE(PG8_SB(1, 1), b3 + hstepB, voffB); PG8_STAGE(PG8_SA(1, 0), a3, voffA);
            PG8_WAIT_V(8); PG8_WAIT_L(0); PG8_BAR; PG8_MMA(1, 0, At, B0); PG8_MMA(1, 1, At, B1); PG8_BAR; PG8_SCHED;
        }
        if constexpr (ALIGN_EPI) { if (wr == 0) PG8_BAR; }
        E(acc, cur, wr, wc, fr, fq);
        if (!has_next) break;
#pragma unroll
        for (int a = 0; a < 2; ++a)
#pragma unroll
            for (int b = 0; b < 2; ++b)
#pragma unroll
                for (int m = 0; m < 4; ++m)
#pragma unroll
                    for (int n = 0; n < 2; ++n) acc[a][b][m][n] = (f32x4){0.f, 0.f, 0.f, 0.f};
        cur = nxt; cA = nA; cB = nB; ++ui;
        if constexpr (ALIGN_EPI) { if (wr == 1) PG8_BAR; }
    }
    PG8_WAIT_V(0);
    if constexpr (!ALIGN_EPI) { if (wr == 0) PG8_BAR; }
    PG8_BAR;
#undef PG8_SA
#undef PG8_SB
#undef PG8_STAGE
#undef PG8_LDA
#undef PG8_LDB
#undef PG8_MMA
#undef PG8_WAIT_V
#undef PG8_WAIT_L
#undef PG8_BAR
#undef PG8_SCHED
}
}

struct Args { const float* in[21]; float* out; unsigned char* ws; };
enum { I_X = 0, I_MIXN, I_FFNN, I_WQKV, I_QG, I_KG, I_SINK, I_WO, I_WIN, I_RCW, I_RCB, I_WA, I_BA, I_WI, I_BI, I_LAM, I_WOUT, I_WUP, I_FCW, I_FCB, I_WDN };

__device__ __forceinline__ float wave_sum(float v) {
#pragma unroll
    for (int o = 1; o < 64; o <<= 1) v += __shfl_xor(v, o);
    return v;
}

struct TDesc { const float* W; const float* gain; bf16_t* O; int ldw, ldt; };
__device__ __forceinline__ void titem_load(const TDesc& d, f32x4 (&v)[16], f32x4 (&g)[4], int lane) {
    const int lr = lane >> 4, ln = lane & 15;
    const float* wp = d.W + (size_t)(4 * lr) * d.ldw + 4 * ln;
#pragma unroll
    for (int i = 0; i < 16; ++i) v[i] = *(const f32x4*)(wp + (size_t)(16 * (i >> 2) + (i & 3)) * d.ldw);
#pragma unroll
    for (int b = 0; b < 4; ++b) g[b] = d.gain ? *(const f32x4*)(d.gain + 16 * b + 4 * lr) : (f32x4){1.f, 1.f, 1.f, 1.f};
}
__device__ __forceinline__ void titem_store(const TDesc& d, const f32x4 (&v)[16], const f32x4 (&g)[4], LAS unsigned char* scr, int lane) {
    const int lr = lane >> 4, ln = lane & 15;
#pragma unroll
    for (int b = 0; b < 4; ++b)
#pragma unroll
        for (int e = 0; e < 4; ++e) {
            u32x2 w; w.x = cvt_pk_bf16(v[4 * b + 0][e] * g[b][0], v[4 * b + 1][e] * g[b][1]); w.y = cvt_pk_bf16(v[4 * b + 2][e] * g[b][2], v[4 * b + 3][e] * g[b][3]);
            *(LAS u32x2*)(scr + (4 * ln + e) * 136 + (16 * b + 4 * lr) * 2) = w; }
    asm volatile("s_waitcnt lgkmcnt(0)" ::: "memory");
    const int rn = lane >> 3, c = lane & 7;
#pragma unroll
    for (int j = 0; j < 8; ++j) { const int n = 8 * j + rn;
        const u32x2 lo = *(const LAS u32x2*)(scr + n * 136 + 16 * c), hi = *(const LAS u32x2*)(scr + n * 136 + 16 * c + 8);
        *(u32x4*)(d.O + (size_t)n * d.ldt + 8 * c) = (u32x4){lo.x, lo.y, hi.x, hi.y}; }
    asm volatile("s_waitcnt lgkmcnt(0)" ::: "memory");
}

struct Job { const float* W; const float* gain; bf16_t* WT; int ldw, ldt, K, N, gate_which; };
__device__ __forceinline__ Job get_job(const Args& a, int jb) {
    Job J; J.gain = nullptr; J.gate_which = -1; unsigned char* ws = a.ws;
    int kind, idx;
    if (jb < 8) { const int j = jb >> 2, l = 2 * j; kind = jb & 3; idx = (kind == 0 || kind == 3) ? j : l; }
    else { const int r = (jb - 8) % 20, j = (jb - 8) / 20, l = 2 * j + 1;
        if (r < 4) { kind = r == 0 ? 4 : r == 1 ? 5 : r == 2 ? 1 : 2; idx = (r < 2) ? j : l; } else { kind = 6; idx = j * 16 + (r - 4); } }
    if (kind == 0) { J.W = a.in[I_WQKV] + (size_t)idx * D * QKVD; J.gain = a.in[I_MIXN] + (size_t)(2 * idx) * D; J.WT = (bf16_t*)(ws + WS_WQKV) + (size_t)idx * QKVD * D; J.ldw = QKVD; J.ldt = D; J.K = D; J.N = QKVD; }
    else if (kind == 1) { J.W = a.in[I_WUP] + (size_t)idx * D * FF2; J.gain = a.in[I_FFNN] + (size_t)idx * D; J.WT = (bf16_t*)(ws + WS_WUP) + (size_t)idx * FF2 * D; J.ldw = FF2; J.ldt = D; J.K = D; J.N = FF2; J.gate_which = 2; }
    else if (kind == 2) { J.W = a.in[I_WDN] + (size_t)idx * FF * D; J.WT = (bf16_t*)(ws + WS_WDN) + (size_t)idx * D * FF; J.ldw = D; J.ldt = FF; J.K = FF; J.N = D; }
    else if (kind == 3) { J.W = a.in[I_WO] + (size_t)idx * D * D; J.WT = (bf16_t*)(ws + WS_WO) + (size_t)idx * D * D; J.ldw = D; J.ldt = D; J.K = D; J.N = D; }
    else if (kind == 4) { J.W = a.in[I_WIN] + (size_t)idx * D * 2 * D; J.gain = a.in[I_MIXN] + (size_t)(2 * idx + 1) * D; J.WT = (bf16_t*)(ws + WS_WIN) + (size_t)idx * 2 * D * D; J.ldw = 2 * D; J.ldt = D; J.K = D; J.N = 2 * D; }
    else if (kind == 5) { J.W = a.in[I_WOUT] + (size_t)idx * D * D; J.WT = (bf16_t*)(ws + WS_WOUT) + (size_t)idx * D * D; J.ldw = D; J.ldt = D; J.K = D; J.N = D; }
    else { const int j = idx >> 4, which = (idx >> 3) & 1, h = idx & 7;
      J.W = a.in[which ? I_WI : I_WA] + ((size_t)j * 8 + h) * 256 * 256; J.WT = (bf16_t*)(ws + WS_WG) + (size_t)j * 4096 * 256 + (size_t)h * 512 * 256;
      J.ldw = 256; J.ldt = 256; J.K = 256; J.N = 256; J.gate_which = which; }
    return J;
}

struct TIter {
    const Args* a; int jb, jb1, gw, NGW, base, it, nit, nN; Job J;
    __device__ __forceinline__ void open() { J = get_job(*a, jb); nN = J.N / 64; nit = (J.K / 64) * nN; int first = (gw - base) % NGW; if (first < 0) first += NGW; it = first; }
    __device__ __forceinline__ bool next(TDesc& d) {
        while (jb < jb1) {
            if (it < nit) {
                const int kb = it / nN, nb = it % nN, k0 = 64 * kb, n0 = 64 * nb; int orow0 = n0;
                if (J.gate_which == 2) { const int ch = n0 < FF ? n0 : n0 - FF; orow0 = 256 * (ch >> 7) + (n0 < FF ? 0 : 128) + (ch & 127); }
                else if (J.gate_which >= 0) orow0 = 256 * (n0 >> 7) + 128 * J.gate_which + (n0 & 127);
                d.W = J.W + (size_t)k0 * J.ldw + n0; d.gain = J.gain ? J.gain + k0 : nullptr; d.O = J.WT + (size_t)orow0 * J.ldt + k0; d.ldw = J.ldw; d.ldt = J.ldt;
                it += NGW; return true; }
            base = (base + nit) % NGW; ++jb; if (jb < jb1) open();
        }
        return false;
    }
};
__device__ __forceinline__ void convert_jobs(const Args& a, LAS unsigned char* lds, int jb0, int jb1, int worker_wg, int n_wg) {
    int tid = threadIdx.x; asm volatile("" : "+v"(tid));
    const int lane = tid & 63, wave = __builtin_amdgcn_readfirstlane(tid >> 6);
    LAS unsigned char* scr = lds + wave * 8704;
    TIter itr; itr.a = &a; itr.jb = jb0; itr.jb1 = jb1; itr.gw = worker_wg * 8 + wave; itr.NGW = n_wg * 8; itr.base = 0;
    if (jb0 >= jb1) return;
    itr.open();
    TDesc dA, dB; f32x4 vA[16], vB[16], gA[4], gB[4];
    bool hA = itr.next(dA); if (hA) titem_load(dA, vA, gA, lane);
    while (hA) {
        const bool hB = itr.next(dB); if (hB) titem_load(dB, vB, gB, lane);
        titem_store(dA, vA, gA, scr, lane);
        if (!hB) break;
        hA = itr.next(dA); if (hA) titem_load(dA, vA, gA, lane);
        titem_store(dB, vB, gB, scr, lane);
    }
}

__device__ __forceinline__ void prologue(const Args& a, LAS unsigned char* lds, int vcu, int G) {
    const int tid = threadIdx.x, lane = tid & 63, wave = __builtin_amdgcn_readfirstlane(tid >> 6);
    const int gw = vcu * 8 + wave, NGW = G * 8;
    {
        const float* x = a.in[I_X]; bf16_t* XB = (bf16_t*)(a.ws + WS_XB); unsigned long long* SSQ = (unsigned long long*)(a.ws + WS_SSQ);
        for (int m = gw; m < T; m += NGW) {
            const f32x4* xr = (const f32x4*)(x + (size_t)m * D) + lane; float s = 0.f;
            unsigned long long* o8 = (unsigned long long*)(XB + (size_t)m * D) + lane;
#pragma unroll
            for (int j = 0; j < 8; ++j) { const f32x4 v = xr[64 * j]; s += (v[0] * v[0] + v[1] * v[1]) + (v[2] * v[2] + v[3] * v[3]);
                o8[64 * j] = (unsigned long long)cvt_pk_bf16(v[0], v[1]) | ((unsigned long long)cvt_pk_bf16(v[2], v[3]) << 32); }
            s = wave_sum(s);
            if (lane < 8) SSQ[(size_t)lane * T + m] = lane == 0 ? (unsigned long long)(s * SSQ_SCALE) : 0ull;
        }
    }
    convert_jobs(a, lds, 0, DEFER_CONV ? 8 : 48, vcu, G);
}

__device__ __forceinline__ void ffn_fix_phase(const float* halo, const float* cw, const float* cb, bf16_t* ACT, int vcu, int G) {
    int tid = threadIdx.x; asm volatile("" : "+v"(tid)); const int gtid = vcu * 512 + tid, GT = G * 512;
    constexpr int NQ = FF / 4, NTASK = 32 * 2 * NQ;
    for (int task = gtid; task < NTASK; task += GT) {
        const int cq = task % NQ, r = (task / NQ) & 1, pm = task / (2 * NQ), c0 = cq * 4, tc = (c0 >> 7) * 256 + (c0 & 127);
        const f32x4 z = {0.f, 0.f, 0.f, 0.f};
        const float* h0 = halo + (size_t)(pm * 4) * FF2 + tc; const float* hp = halo + (size_t)(pm * 4 - 4) * FF2 + tc;
        const f32x4 g0 = *(const f32x4*)(h0 + (size_t)r * FF2), v0 = *(const f32x4*)(h0 + (size_t)r * FF2 + 128);
        f32x4 g1, v1, g2, v2;
        if (r == 1) { g1 = *(const f32x4*)(h0); v1 = *(const f32x4*)(h0 + 128); if (pm > 0) { g2 = *(const f32x4*)(hp + 3 * (size_t)FF2); v2 = *(const f32x4*)(hp + 3 * (size_t)FF2 + 128); } else { g2 = z; v2 = z; } }
        else if (pm > 0) { g1 = *(const f32x4*)(hp + 3 * (size_t)FF2); v1 = *(const f32x4*)(hp + 3 * (size_t)FF2 + 128); g2 = *(const f32x4*)(hp + 2 * (size_t)FF2); v2 = *(const f32x4*)(hp + 2 * (size_t)FF2 + 128); }
        else { g1 = z; v1 = z; g2 = z; v2 = z; }
        const f32x4 wg0 = *(const f32x4*)(cw + c0), wg1 = *(const f32x4*)(cw + FF2 + c0), wg2 = *(const f32x4*)(cw + 2 * FF2 + c0), bg = *(const f32x4*)(cb + c0);
        const f32x4 wv0 = *(const f32x4*)(cw + FF + c0), wv1 = *(const f32x4*)(cw + FF2 + FF + c0), wv2 = *(const f32x4*)(cw + 2 * FF2 + FF + c0), bv = *(const f32x4*)(cb + FF + c0);
        float o[4];
#pragma unroll
        for (int e = 0; e < 4; ++e) { const float ug = bg[e] + wg0[e] * g2[e] + wg1[e] * g1[e] + wg2[e] * g0[e], uv = bv[e] + wv0[e] * v2[e] + wv1[e] * v1[e] + wv2[e] * v0[e]; o[e] = gelu_tanh(ug) * uv; }
        *(u32x2*)(ACT + (size_t)(pm * 256 + r) * FF + c0) = (u32x2){cvt_pk_bf16(o[0], o[1]), cvt_pk_bf16(o[2], o[3])};
    }
}

__device__ __forceinline__ void rec_conv_phase(const bf16_t* REC, const float* cw, const float* cb, bf16_t* XC, int vcu, int G) {
    int tid = threadIdx.x; asm volatile("" : "+v"(tid)); const int gtid = vcu * 512 + tid, GT = G * 512;
    constexpr int NCG = D / 8, NTASK = (T / 16) * NCG;
    for (int task = gtid; task < NTASK; task += GT) {
        const int cgp = task % NCG, rc = task / NCG, c0 = cgp * 8, t0 = rc * 16;
        float w[4][8], b[8];
#pragma unroll
        for (int k = 0; k < 4; ++k) { const f32x4 a0 = *(const f32x4*)(cw + (size_t)k * D + c0), a1 = *(const f32x4*)(cw + (size_t)k * D + c0 + 4);
#pragma unroll
            for (int e = 0; e < 4; ++e) { w[k][e] = a0[e]; w[k][4 + e] = a1[e]; } }
        { const f32x4 a0 = *(const f32x4*)(cb + c0), a1 = *(const f32x4*)(cb + c0 + 4);
#pragma unroll
            for (int e = 0; e < 4; ++e) { b[e] = a0[e]; b[4 + e] = a1[e]; } }
        float x3[8], x2[8], x1[8];
#pragma unroll
        for (int e = 0; e < 8; ++e) { x3[e] = 0.f; x2[e] = 0.f; x1[e] = 0.f; }
        if (t0 > 0) {
            const u32x4 ra = *(const u32x4*)(REC + (size_t)(t0 - 3) * 2 * D + c0), rb = *(const u32x4*)(REC + (size_t)(t0 - 2) * 2 * D + c0), rc2 = *(const u32x4*)(REC + (size_t)(t0 - 1) * 2 * D + c0);
#pragma unroll
            for (int e = 0; e < 4; ++e) { x3[2 * e] = bflo(ra[e]); x3[2 * e + 1] = bfhi(ra[e]); x2[2 * e] = bflo(rb[e]); x2[2 * e + 1] = bfhi(rb[e]); x1[2 * e] = bflo(rc2[e]); x1[2 * e + 1] = bfhi(rc2[e]); }
        }
#pragma unroll 4
        for (int r = 0; r < 16; ++r) {
            const int t = t0 + r;
            const u32x4 rr = *(const u32x4*)(REC + (size_t)t * 2 * D + c0);
            float x0[8], o[8];
#pragma unroll
            for (int e = 0; e < 4; ++e) { x0[2 * e] = bflo(rr[e]); x0[2 * e + 1] = bfhi(rr[e]); }
#pragma unroll
            for (int e = 0; e < 8; ++e) { o[e] = b[e] + w[0][e] * x3[e] + w[1][e] * x2[e] + w[2][e] * x1[e] + w[3][e] * x0[e]; x3[e] = x2[e]; x2[e] = x1[e]; x1[e] = x0[e]; }
            u32x4 wv; wv.x = cvt_pk_bf16(o[0], o[1]); wv.y = cvt_pk_bf16(o[2], o[3]); wv.z = cvt_pk_bf16(o[4], o[5]); wv.w = cvt_pk_bf16(o[6], o[7]);
            *(u32x4*)(XC + (size_t)t * D + c0) = wv;
        }
    }
}

__device__ __forceinline__ float bfe(const u32x4& v, int e) { const unsigned w = v[e >> 1]; return (e & 1) ? bfhi(w) : bflo(w); }
__device__ __forceinline__ void scan1_phase(const bf16_t* GP, const bf16_t* XC, const float* ba, const float* bi, const float* lam, bf16_t* LB, bf16_t* UB, float* E, float* AP, int blk, int G) {
    int tid = threadIdx.x; asm volatile("" : "+v"(tid));
    for (int unit = blk; unit < 256; unit += G) {
        const int sc = unit * 2 + (tid >> 8), ch = (tid & 255) * 8, gcol = (ch >> 7) * 256 + (ch & 127);
        float vba[8], vbi[8], vsp[8];
        { const f32x4 a0 = *(const f32x4*)(ba + ch), a1 = *(const f32x4*)(ba + ch + 4), b0 = *(const f32x4*)(bi + ch), b1 = *(const f32x4*)(bi + ch + 4), l0 = *(const f32x4*)(lam + ch), l1 = *(const f32x4*)(lam + ch + 4);
#pragma unroll
          for (int e = 0; e < 4; ++e) { vba[e] = a0[e]; vba[4 + e] = a1[e]; vbi[e] = b0[e]; vbi[4 + e] = b1[e]; vsp[e] = -8.0f * LOG2E * log1pf(__expf(-l0[e])); vsp[4 + e] = -8.0f * LOG2E * log1pf(__expf(-l1[e])); } }
        float h[8], pr[8];
#pragma unroll
        for (int e = 0; e < 8; ++e) { h[e] = 0.f; pr[e] = 1.f; }
        const bf16_t* gp = GP + (size_t)(sc * 16) * 4096 + gcol; const bf16_t* xc = XC + (size_t)(sc * 16) * D + ch;
        bf16_t* lb = LB + (size_t)(sc * 16) * D + ch; bf16_t* ub = UB + (size_t)(sc * 16) * D + ch;
#pragma unroll 4
        for (int r = 0; r < 16; ++r) {
            const u32x4 pa = *(const u32x4*)(gp + (size_t)r * 4096), pi = *(const u32x4*)(gp + (size_t)r * 4096 + 128), xv = *(const u32x4*)(xc + (size_t)r * D);
            float l[8];
#pragma unroll
            for (int e = 0; e < 8; ++e) l[e] = vsp[e] * sigmoidf_(bfe(pa, e) + vba[e]);
            const u32x4 lpk = {cvt_pk_bf16(l[0], l[1]), cvt_pk_bf16(l[2], l[3]), cvt_pk_bf16(l[4], l[5]), cvt_pk_bf16(l[6], l[7])};
            float a[8], u[8];
#pragma unroll
            for (int e = 0; e < 8; ++e) { a[e] = __builtin_amdgcn_exp2f(bfe(lpk, e)); u[e] = sqrtf(fmaxf(1.0f - a[e] * a[e], 0.f)) * sigmoidf_(bfe(pi, e) + vbi[e]) * bfe(xv, e); }
            const u32x4 upk = {cvt_pk_bf16(u[0], u[1]), cvt_pk_bf16(u[2], u[3]), cvt_pk_bf16(u[4], u[5]), cvt_pk_bf16(u[6], u[7])};
            *(u32x4*)(lb + (size_t)r * D) = lpk; *(u32x4*)(ub + (size_t)r * D) = upk;
#pragma unroll
            for (int e = 0; e < 8; ++e) { h[e] = a[e] * h[e] + bfe(upk, e); pr[e] *= a[e]; }
        }
        float* eo = E + (size_t)sc * D + ch; float* po = AP + (size_t)sc * D + ch;
        *(f32x4*)(eo) = (f32x4){h[0], h[1], h[2], h[3]}; *(f32x4*)(eo + 4) = (f32x4){h[4], h[5], h[6], h[7]};
        *(f32x4*)(po) = (f32x4){pr[0], pr[1], pr[2], pr[3]}; *(f32x4*)(po + 4) = (f32x4){pr[4], pr[5], pr[6], pr[7]};
    }
}
__device__ __forceinline__ void scanc_phase(const float* E, const float* AP, float* CIN, LAS unsigned char* lds, int blk, int G) {
    int tid = threadIdx.x; asm volatile("" : "+v"(tid));
    LAS float* sP = (LAS float*)lds; LAS float* sE = sP + 512;
    const int k = tid & 7, g = tid >> 3;
    for (int unit = blk; unit < 256; unit += G) {
        const int ch = unit * 8 + k;
        float e[8], p[8];
#pragma unroll
        for (int i = 0; i < 8; ++i) { e[i] = E[(size_t)(g * 8 + i) * D + ch]; p[i] = AP[(size_t)(g * 8 + i) * D + ch]; }
        float Pg = 1.f, Eg = 0.f;
#pragma unroll
        for (int i = 0; i < 8; ++i) { Eg = p[i] * Eg + e[i]; Pg *= p[i]; }
        sP[tid] = Pg; sE[tid] = Eg;
        __syncthreads();
        if (tid < 8) { float hc = 0.f;
            for (int gg = 0; gg < 64; ++gg) { const float Pq = sP[gg * 8 + tid], Eq = sE[gg * 8 + tid]; sE[gg * 8 + tid] = hc; hc = Pq * hc + Eq; } }
        __syncthreads();
        float hc = sE[tid];
#pragma unroll
        for (int i = 0; i < 8; ++i) { CIN[(size_t)(g * 8 + i) * D + ch] = hc; hc = p[i] * hc + e[i]; }
        __syncthreads();
    }
}
__device__ __forceinline__ void scan2_phase(const bf16_t* LB, const bf16_t* UB, const float* CIN, const bf16_t* REC, bf16_t* HG, int blk, int G) {
    int tid = threadIdx.x; asm volatile("" : "+v"(tid));
    for (int unit = blk; unit < 256; unit += G) {
        const int sc = unit * 2 + (tid >> 8), ch = (tid & 255) * 8;
        float h[8];
        { const f32x4 c0 = *(const f32x4*)(CIN + (size_t)sc * D + ch), c1 = *(const f32x4*)(CIN + (size_t)sc * D + ch + 4);
#pragma unroll
          for (int e = 0; e < 4; ++e) { h[e] = c0[e]; h[4 + e] = c1[e]; } }
        const bf16_t* lb = LB + (size_t)(sc * 16) * D + ch; const bf16_t* ub = UB + (size_t)(sc * 16) * D + ch;
        const bf16_t* yb = REC + (size_t)(sc * 16) * 2 * D + D + ch; bf16_t* hg = HG + (size_t)(sc * 16) * D + ch;
#pragma unroll 4
        for (int r = 0; r < 16; ++r) {
            const u32x4 lpk = *(const u32x4*)(lb + (size_t)r * D), upk = *(const u32x4*)(ub + (size_t)r * D), y = *(const u32x4*)(yb + (size_t)r * 2 * D);
            float o[8];
#pragma unroll
            for (int e = 0; e < 8; ++e) h[e] = __builtin_amdgcn_exp2f(bfe(lpk, e)) * h[e] + bfe(upk, e);
#pragma unroll
            for (int e = 0; e < 4; ++e) { const f32x2 gy = gelu_tanh2((f32x2){bflo(y[e]), bfhi(y[e])}); o[2 * e] = h[2 * e] * gy.x; o[2 * e + 1] = h[2 * e + 1] * gy.y; }
            *(u32x4*)(hg + (size_t)r * D) = (u32x4){cvt_pk_bf16(o[0], o[1]), cvt_pk_bf16(o[2], o[3]), cvt_pk_bf16(o[4], o[5]), cvt_pk_bf16(o[6], o[7])};
        }
    }
}

__device__ __forceinline__ int crow(int r, int hi) { return (r & 3) + 8 * (r >> 2) + 4 * hi; }
__device__ __forceinline__ void attn_phase(LAS unsigned char* lds, const bf16_t* QKV, bf16_t* AO, const float* qg, const float* kg, const float* sinks, int vcu, int G) {
    int tid = threadIdx.x; asm volatile("" : "+v"(tid));
    const int lane = tid & 63, wid = __builtin_amdgcn_readfirstlane(tid >> 6), r32 = lane & 31, hi = lane >> 5;
    constexpr int KS_STRIDE = 144, VT_STRIDE = 528, VT_OFF = 256 * KS_STRIDE;
    LAS unsigned char* Ks = lds; LAS unsigned char* VT = lds + VT_OFF;
    for (int unit = vcu; unit < 512; unit += G) {
        const int qb = unit >> 3, kvh = unit & 7;
#pragma unroll
        for (int i = 0; i < 4; ++i) {
            const int id = tid + 512 * i, w = id >> 3, c = id & 7; int grow = 128 * (qb - 1) + w; if (grow < 0) grow = 0;
            const bf16_t* rowp = QKV + (size_t)grow * QKVD;
            const u32x4 kr = *(const u32x4*)(rowp + D + kvh * 64 + c * 8), vr = *(const u32x4*)(rowp + D + 512 + kvh * 64 + c * 8);
            float kf[8] = {bflo(kr.x), bfhi(kr.x), bflo(kr.y), bfhi(kr.y), bflo(kr.z), bfhi(kr.z), bflo(kr.w), bfhi(kr.w)};
            float ss = 0.f;
#pragma unroll
            for (int e = 0; e < 8; ++e) ss += kf[e] * kf[e];
            ss += __shfl_xor(ss, 1); ss += __shfl_xor(ss, 2); ss += __shfl_xor(ss, 4);
            const float rs = rsqrtf(ss * (1.0f / 64.0f) + EPS);
            const f32x4 g0 = *(const f32x4*)(kg + c * 8) * *(const f32x4*)(qg + c * 8), g1 = *(const f32x4*)(kg + c * 8 + 4) * *(const f32x4*)(qg + c * 8 + 4);
            u32x4 ko; ko.x = cvt_pk_bf16(kf[0] * rs * g0[0], kf[1] * rs * g0[1]); ko.y = cvt_pk_bf16(kf[2] * rs * g0[2], kf[3] * rs * g0[3]);
            ko.z = cvt_pk_bf16(kf[4] * rs * g1[0], kf[5] * rs * g1[1]); ko.w = cvt_pk_bf16(kf[6] * rs * g1[2], kf[7] * rs * g1[3]);
            *(LAS u32x4*)(Ks + w * KS_STRIDE + c * 16) = ko;
            const int pos = (w & ~15) + 8 * ((w >> 2) & 1) + (w & 3) + 4 * ((w >> 3) & 1);
            LAS bf16_t* vt = (LAS bf16_t*)(VT + (c * 8) * VT_STRIDE + pos * 2);
            vt[0 * (VT_STRIDE / 2)] = (bf16_t)(vr.x & 0xffff); vt[1 * (VT_STRIDE / 2)] = (bf16_t)(vr.x >> 16);
            vt[2 * (VT_STRIDE / 2)] = (bf16_t)(vr.y & 0xffff); vt[3 * (VT_STRIDE / 2)] = (bf16_t)(vr.y >> 16);
            vt[4 * (VT_STRIDE / 2)] = (bf16_t)(vr.z & 0xffff); vt[5 * (VT_STRIDE / 2)] = (bf16_t)(vr.z >> 16);
            vt[6 * (VT_STRIDE / 2)] = (bf16_t)(vr.w & 0xffff); vt[7 * (VT_STRIDE / 2)] = (bf16_t)(vr.w >> 16);
        }
        __syncthreads();
        const int head = kvh * 4 + (wid >> 1);
        const float sink2 = sinks[head] * LOG2E;
#pragma unroll 1
        for (int st = 0; st < 2; ++st) {
            const int o32 = 64 * (wid & 1) + 32 * st;
            const size_t qrow = (size_t)(128 * qb + o32 + r32);
            bf16x8 qr[4];
            {
                float qf[4][8]; float ss = 0.f;
#pragma unroll
                for (int d0 = 0; d0 < 4; ++d0) { const u32x4 q = *(const u32x4*)(QKV + qrow * QKVD + head * 64 + d0 * 16 + hi * 8);
                    qf[d0][0] = bflo(q.x); qf[d0][1] = bfhi(q.x); qf[d0][2] = bflo(q.y); qf[d0][3] = bfhi(q.y); qf[d0][4] = bflo(q.z); qf[d0][5] = bfhi(q.z); qf[d0][6] = bflo(q.w); qf[d0][7] = bfhi(q.w);
#pragma unroll
                    for (int e = 0; e < 8; ++e) ss += qf[d0][e] * qf[d0][e]; }
                ss += __shfl_xor(ss, 32);
                const float rs = rsqrtf(ss * (1.0f / 64.0f) + EPS) * (0.125f * LOG2E);
#pragma unroll
                for (int d0 = 0; d0 < 4; ++d0) {
                    u32x4 w; w.x = cvt_pk_bf16(qf[d0][0] * rs, qf[d0][1] * rs); w.y = cvt_pk_bf16(qf[d0][2] * rs, qf[d0][3] * rs);
                    w.z = cvt_pk_bf16(qf[d0][4] * rs, qf[d0][5] * rs); w.w = cvt_pk_bf16(qf[d0][6] * rs, qf[d0][7] * rs);
                    qr[d0] = __builtin_bit_cast(bf16x8, w); }
            }
            f32x16 p[5];
#pragma unroll
            for (int t = 0; t < 5; ++t) {
                const int kbase = o32 + 32 * t;
                f32x16 accp = {};
#pragma unroll
                for (int d0 = 0; d0 < 4; ++d0) { const bf16x8 kf = *(const LAS bf16x8*)(Ks + (kbase + r32) * KS_STRIDE + d0 * 32 + hi * 16);
                    accp = __builtin_amdgcn_mfma_f32_32x32x16_bf16(kf, qr[d0], accp, 0, 0, 0); }
                p[t] = accp;
            }
            const int vq = r32 - 4 * hi;
#pragma unroll
            for (int r = 0; r < 16; ++r) { const int cr = (r & 3) + 8 * (r >> 2);
                p[0][r] = (cr > vq) ? p[0][r] : -INFINITY; p[4][r] = (cr <= vq) ? p[4][r] : -INFINITY; }
            if (qb == 0) {
                const int nfirst = 4 - (o32 >> 5);
#pragma unroll
                for (int t = 0; t < 4; ++t) if (t < nfirst) {
#pragma unroll
                    for (int r = 0; r < 16; ++r) p[t][r] = -INFINITY; }
            }
            float mx = sink2;
#pragma unroll
            for (int t = 0; t < 5; ++t)
#pragma unroll
                for (int r = 0; r < 16; ++r) mx = fmaxf(mx, p[t][r]);
            mx = fmaxf(mx, __shfl_xor(mx, 32));
            float l = 0.f;
#pragma unroll
            for (int t = 0; t < 5; ++t)
#pragma unroll
                for (int r = 0; r < 16; ++r) { const float e = __builtin_amdgcn_exp2f(p[t][r] - mx); p[t][r] = e; l += e; }
            l += __shfl_xor(l, 32);
            l += __builtin_amdgcn_exp2f(sink2 - mx);
            const float inv = 1.0f / l;
            f32x16 o0 = {}, o1 = {};
#pragma unroll
            for (int t = 0; t < 5; ++t)
#pragma unroll
                for (int s = 0; s < 2; ++s) {
                    u32x4 pw; pw.x = cvt_pk_bf16(p[t][8 * s + 0], p[t][8 * s + 1]); pw.y = cvt_pk_bf16(p[t][8 * s + 2], p[t][8 * s + 3]); pw.z = cvt_pk_bf16(p[t][8 * s + 4], p[t][8 * s + 5]); pw.w = cvt_pk_bf16(p[t][8 * s + 6], p[t][8 * s + 7]);
                    const bf16x8 pb = __builtin_bit_cast(bf16x8, pw);
                    const int g16 = (o32 + 32 * t) / 16 + s;
                    const bf16x8 vf0 = *(const LAS bf16x8*)(VT + (r32) * VT_STRIDE + g16 * 32 + hi * 16);
                    const bf16x8 vf1 = *(const LAS bf16x8*)(VT + (32 + r32) * VT_STRIDE + g16 * 32 + hi * 16);
                    o0 = __builtin_amdgcn_mfma_f32_32x32x16_bf16(vf0, pb, o0, 0, 0, 0);
                    o1 = __builtin_amdgcn_mfma_f32_32x32x16_bf16(vf1, pb, o1, 0, 0, 0);
                }
            bf16_t* orow = AO + qrow * D + head * 64;
#pragma unroll
            for (int rg = 0; rg < 4; ++rg) {
                u32x2 w0, w1;
                w0.x = cvt_pk_bf16(o0[4 * rg + 0] * inv, o0[4 * rg + 1] * inv); w0.y = cvt_pk_bf16(o0[4 * rg + 2] * inv, o0[4 * rg + 3] * inv);
                w1.x = cvt_pk_bf16(o1[4 * rg + 0] * inv, o1[4 * rg + 1] * inv); w1.y = cvt_pk_bf16(o1[4 * rg + 2] * inv, o1[4 * rg + 3] * inv);
                *(u32x2*)(orow + 8 * rg + 4 * hi) = w0; *(u32x2*)(orow + 32 + 8 * rg + 4 * hi) = w1;
            }
        }
        __syncthreads();
    }
}


__device__ __forceinline__ void touch_phase(const u32x4* wp, int nchunk, unsigned* sink, int vcu, int G) {
    int tid = threadIdx.x; asm volatile("" : "+v"(tid));
    unsigned accx = 0u;
#pragma unroll 4
    for (int c = vcu * 512 + tid; c < nchunk; c += G * 512) { const u32x4 t = wp[c]; accx ^= t.x ^ t.y ^ t.z ^ t.w; }
    if (accx == 0x9e3779b9u && nchunk < 0) *sink = accx;
}

#define GAS __attribute__((address_space(1)))
#define XB_TMO      128
#define XB_XCNT(j)  (256  + 64 * (j))
#define XB_XSUB(j)  (1280 + 64 * (j))
#define XB_XGEN(j)  (2304 + 64 * (j))
#define XB_TOP      3328
#define XB_TOPGEN   3392
#define XCD_BAR_WORDS 3456
#define XB_SPIN_CAP (1u << 18)

__device__ __forceinline__ unsigned xb_ld(unsigned* p)              { return __hip_atomic_load(p, __ATOMIC_RELAXED, __HIP_MEMORY_SCOPE_AGENT); }
__device__ __forceinline__ unsigned xb_add(unsigned* p, unsigned v) { return __hip_atomic_fetch_add(p, v, __ATOMIC_RELAXED, __HIP_MEMORY_SCOPE_AGENT); }
__device__ __forceinline__ unsigned xb_xcc_id() { return (unsigned)__builtin_amdgcn_s_getreg((3 << 11) | 20) & 0xFu; }
#define XB_SPIN(cond, bar) do { unsigned _sp = 0; while (cond) { __builtin_amdgcn_s_sleep(1); \
    if ((++_sp & 255u) == 0u) { if (xb_ld(&(bar)[XB_TMO])) break; if (_sp > XB_SPIN_CAP) { atomicAdd(&(bar)[XB_TMO], 1u); break; } } } } while (0)

struct XcdBarrier {
    unsigned* bar; unsigned x;
    volatile LAS unsigned* st;
};

__device__ __forceinline__ XcdBarrier xcd_barrier_post(unsigned* bar, volatile LAS unsigned* st) {
    XcdBarrier b; b.bar = bar; b.x = xb_xcc_id(); b.st = st;
    if (threadIdx.x == 0) (void)xb_add(&bar[XB_XCNT(b.x)], 1u);
    return b;
}
__device__ __forceinline__ void xcd_barrier_complete(unsigned* bar, unsigned x, unsigned& nloc, unsigned& nx) {
    const unsigned G = gridDim.x * gridDim.y * gridDim.z;
    unsigned sum, cnt, mine, sp = 0u;
    for (;;) {
        sum = 0u; cnt = 0u; mine = 0u;
#pragma unroll
        for (unsigned j = 0; j < 16; ++j) { const unsigned c = xb_ld(&bar[XB_XCNT(j)]); sum += c; cnt += (c > 0u) ? 1u : 0u; mine = (j == x) ? c : mine; }
        if (sum == G) break;
        __builtin_amdgcn_s_sleep(1);
        if ((++sp & 255u) == 0u) { if (xb_ld(&bar[XB_TMO])) break; if (sp > XB_SPIN_CAP) { atomicAdd(&bar[XB_TMO], 1u); break; } }
    }
    nloc = mine > 0u ? mine : 1u; nx = cnt > 0u ? cnt : 1u;
}

__device__ __forceinline__ void xcd_barrier(const XcdBarrier& b) {
    asm volatile("s_waitcnt vmcnt(0)" ::: "memory");
    __syncthreads();
    if (threadIdx.x == 0) {
        unsigned* bar = b.bar;
        __builtin_amdgcn_s_waitcnt(0);
        unsigned nloc = b.st[0], nx = b.st[1];
        if (nloc == 0u) { xcd_barrier_complete(bar, b.x, nloc, nx); b.st[0] = nloc; b.st[1] = nx; }
        const unsigned old = xb_add(&bar[XB_XSUB(b.x)], 1u);
        const unsigned gen = old / nloc;
        if (old + 1u == (gen + 1u) * nloc) {
            __builtin_amdgcn_fence(__ATOMIC_RELEASE, "agent");
            asm volatile("s_waitcnt vmcnt(0)" ::: "memory");
            const unsigned og = xb_add(&bar[XB_TOP], 1u);
            const unsigned tg = og / nx;
            if (og + 1u == (tg + 1u) * nx) xb_add(&bar[XB_TOPGEN], 1u);
            else XB_SPIN(xb_ld(&bar[XB_TOPGEN]) == tg, bar);
            __builtin_amdgcn_fence(__ATOMIC_ACQUIRE, "agent");
            xb_add(&bar[XB_XGEN(b.x)], 1u);
            asm volatile("s_waitcnt vmcnt(0)" ::: "memory");
        } else {
            XB_SPIN(xb_ld(&bar[XB_XGEN(b.x)]) == gen, bar);
            __builtin_amdgcn_fence(__ATOMIC_ACQUIRE, "agent");
            asm volatile("s_waitcnt vmcnt(0)" ::: "memory");
        }
    }
    __syncthreads();
}
__global__ void __launch_bounds__(512, 2) fwd_megakernel(Args a) {
    extern __shared__ __attribute__((aligned(16))) unsigned char lds_raw[];
    LAS unsigned char* lds = (LAS unsigned char*)lds_raw;
    cg::grid_group grid = cg::this_grid();
    const int G = gridDim.x, bx = blockIdx.x;
    const int vcu = (G % 8 == 0) ? (bx % 8) * (G / 8) + bx / 8 : bx;

    volatile LAS unsigned* MISC = (volatile LAS unsigned*)(lds + MISC_OFF);
    if (threadIdx.x < 16) MISC[threadIdx.x] = 0u;
    unsigned* barw = (unsigned*)(a.ws + WS_BAR);
    if (bx == 0) for (int i = threadIdx.x; i < XCD_BAR_WORDS; i += 512) barw[i] = 0u;
    __syncthreads();
    prologue(a, lds, vcu, G);
    grid.sync();
    const XcdBarrier xbar = xcd_barrier_post(barw, MISC + 8);

#pragma unroll 1
    for (int step = 0; step < NSTEPS; ++step) {
        int layer, idx;
        if (step < 6) { layer = 0; idx = step; } else if (step < 16) { layer = 1; idx = step - 6; } else if (step < 22) { layer = 2; idx = step - 16; } else { layer = 3; idx = step - 22; }
        int kind = idx;
        if (layer & 1) kind = idx < 4 ? 6 + idx : (idx == 4 ? 12 : (idx < 7 ? 5 + idx : idx - 4));
        const int j = layer >> 1;
        unsigned char* ws = a.ws;
        unsigned long long* SSQ = (unsigned long long*)(ws + WS_SSQ);
        bf16_t* XB = (bf16_t*)(ws + WS_XB); bf16_t* QKV = (bf16_t*)(ws + WS_QKV); bf16_t* AO = (bf16_t*)(ws + WS_AO); bf16_t* REC = (bf16_t*)(ws + WS_REC); bf16_t* XC = (bf16_t*)(ws + WS_XC);
        bf16_t* GP = (bf16_t*)(ws + WS_GA); bf16_t* HG = (bf16_t*)(ws + WS_HG); bf16_t* P = (bf16_t*)(ws + WS_P); bf16_t* ACT = (bf16_t*)(ws + WS_ACT);
        float* CE = (float*)(ws + WS_CARRY); float* CAP = CE + 512 * D; float* CIN = CAP + 512 * D; bf16_t* LB = (bf16_t*)(ws + WS_GU); bf16_t* UB = LB + (size_t)T * D;
        if (kind == 3) {
            pg8::Gemm g; g.M = T; g.lda = D; g.ldb = D; g.K = D; g.agrp = 0; g.A = XB; g.Bt = (const bf16_t*)(ws + WS_WUP) + (size_t)layer * FF2 * D; g.N = FF2;
            pg8::EpiConvActP E; E.ACT = ACT; E.ssq = SSQ + (size_t)(2 * layer + 1) * T; E.cw = a.in[I_FCW] + (size_t)layer * 3 * FF2; E.cb = a.in[I_FCB] + (size_t)layer * FF2; E.halo = (float*)P; E.hl = lds + 131072;
            pg8::StaticOrder S; S.init(T, FF2, G, bx);
            pg8::gemm_phase<pg8::EpiConvActP, true, true>(lds, g, S, E);
        } else if (kind == 0 || kind == 6 || kind == 8) {
            pg8::Gemm g; pg8::EpiScaleBf16 E; g.M = T; g.lda = D; g.ldb = D; g.K = D; g.agrp = 0; g.A = XB;
            if (kind == 0)      { g.Bt = (const bf16_t*)(ws + WS_WQKV) + (size_t)j * QKVD * D; g.N = QKVD; E.O = QKV; E.ldc = QKVD; E.ssq = SSQ + (size_t)(2 * layer) * T; }
            else if (kind == 6) { g.Bt = (const bf16_t*)(ws + WS_WIN) + (size_t)j * 2 * D * D; g.N = 2 * D; E.O = REC; E.ldc = 2 * D; E.ssq = SSQ + (size_t)(2 * layer) * T; }
            else                { g.A = XC; g.Bt = (const bf16_t*)(ws + WS_WG) + (size_t)j * 4096 * 256; g.N = 4096; g.K = 256; g.ldb = 256; g.agrp = 512; E.O = GP; E.ldc = 4096; E.ssq = nullptr; }
            pg8::StaticOrder S; S.init(T, g.N, G, bx);
            pg8::gemm_phase<pg8::EpiScaleBf16, true>(lds, g, S, E);
            if (DEFER_CONV && kind == 0) {
                const int first_idle = 384 - G, jb0 = layer == 0 ? 8 : 28;
                if (first_idle > 0 && first_idle < G) { if (bx >= first_idle) convert_jobs(a, lds, jb0, jb0 + 20, bx - first_idle, G - first_idle); }
                else convert_jobs(a, lds, jb0, jb0 + 20, bx, G);
            }
        } else if (kind == 2 || kind == 5 || kind == 11) {
            pg8::Gemm g; pg8::EpiResid E; g.M = T; g.N = D; g.lda = D; g.ldb = D; g.K = D; g.agrp = 0;
            E.xold_f32 = nullptr; E.xnew_f32 = nullptr; E.xb = XB; E.ssq = SSQ + (size_t)(2 * layer + 1) * T;
            if (kind == 2)      { g.A = AO; g.Bt = (const bf16_t*)(ws + WS_WO) + (size_t)j * D * D; if (layer == 0) E.xold_f32 = a.in[I_X]; }
            else if (kind == 11){ g.A = HG; g.Bt = (const bf16_t*)(ws + WS_WOUT) + (size_t)j * D * D; }
            else                { g.A = ACT; g.Bt = (const bf16_t*)(ws + WS_WDN) + (size_t)layer * D * FF; g.K = FF; g.lda = FF; g.ldb = FF; E.ssq = layer < 3 ? SSQ + (size_t)(2 * layer + 2) * T : nullptr; if (layer == 3) E.xnew_f32 = a.out; }
            pg8::StaticOrder S; S.init(T, D, G, bx);
            pg8::gemm_phase<pg8::EpiResid, true>(lds, g, S, E);
        } else if (kind == 1) {
            attn_phase(lds, QKV, AO, a.in[I_QG] + j * 64, a.in[I_KG] + j * 64, a.in[I_SINK] + j * 32, vcu, G);
        } else if (kind == 4) {
            ffn_fix_phase((const float*)P, a.in[I_FCW] + (size_t)layer * 3 * FF2, a.in[I_FCB] + (size_t)layer * FF2, ACT, vcu, G);
            touch_phase((const u32x4*)((const bf16_t*)(ws + WS_WDN) + (size_t)layer * D * FF), D * FF * 2 / 16, (unsigned*)(ws + WS_BAR + 65536), vcu, G);
        } else if (kind == 7) {
            rec_conv_phase(REC, a.in[I_RCW] + (size_t)j * 4 * D, a.in[I_RCB] + (size_t)j * D, XC, vcu, G);
        } else if (kind == 9) {
            scan1_phase(GP, XC, a.in[I_BA] + (size_t)j * D, a.in[I_BI] + (size_t)j * D, a.in[I_LAM] + (size_t)j * D, LB, UB, CE, CAP, vcu, G);
        } else if (kind == 12) {
            scanc_phase(CE, CAP, CIN, lds, vcu, G);
        } else {
            scan2_phase(LB, UB, CIN, REC, HG, vcu, G);
        }
        if (step < NSTEPS - 1) xcd_barrier(xbar);
    }
}

extern "C" void kernel_launch(void* const* d_in, const int* in_sizes, int n_in, void* d_out, int out_size, void* d_ws, size_t ws_size, hipStream_t stream) {
    static int grid = 0;
    if (grid == 0) {
        if (n_in != 21 || out_size != T * D || ws_size < WS_END) { fprintf(stderr, "kernel_launch: unexpected problem (n_in %d out %d ws %zu)\n", n_in, out_size, ws_size); grid = -1; return; }
        int dev = 0, cus = 0, per_cu = 0;
        hipGetDevice(&dev); hipDeviceGetAttribute(&cus, hipDeviceAttributeMultiprocessorCount, dev);
        if (hipFuncSetAttribute((const void*)fwd_megakernel, hipFuncAttributeMaxDynamicSharedMemorySize, LDS_BYTES) != hipSuccess) { fprintf(stderr, "kernel_launch: hipFuncSetAttribute failed\n"); grid = -1; return; }
        if (hipOccupancyMaxActiveBlocksPerMultiprocessor(&per_cu, (const void*)fwd_megakernel, 512, LDS_BYTES) != hipSuccess || per_cu < 1) { fprintf(stderr, "kernel_launch: occupancy query says %d\n", per_cu); per_cu = 1; }
        (void)hipGetLastError();
        grid = cus * 1;
    }
    if (grid < 0) return;
    Args a{};
    for (int i = 0; i < 21; ++i) a.in[i] = (const float*)d_in[i];
    a.out = (float*)d_out; a.ws = (unsigned char*)d_ws;
    void* args[] = {&a};
    hipError_t e = hipLaunchCooperativeKernel((const void*)fwd_megakernel, dim3(grid), dim3(512), args, LDS_BYTES, stream);
    if (e != hipSuccess) fprintf(stderr, "cooperative launch failed: %s (grid %d)\n", hipGetErrorString(e), grid);
}
```

```cpp
#include <hip/hip_runtime.h>
#include <hip/hip_cooperative_groups.h>
#include <cstdio>
#include <cstdint>
namespace cg = cooperative_groups;

#define LAS __attribute__((address_space(3)))
typedef unsigned short bf16_t;
typedef short bf16x8 __attribute__((ext_vector_type(8)));
typedef float f32x4 __attribute__((ext_vector_type(4)));
typedef float f32x2 __attribute__((ext_vector_type(2)));
typedef float f32x16 __attribute__((ext_vector_type(16)));
typedef unsigned u32x4 __attribute__((ext_vector_type(4)));
typedef unsigned u32x2 __attribute__((ext_vector_type(2)));

constexpr int T = 8192, D = 2048, QKVD = 3072, FF = 6144, FF2 = 12288;
constexpr float EPS = 1e-6f;
constexpr float LOG2E = 1.4426950408889634f;
constexpr float SSQ_SCALE = 4294967296.0f, SSQ_INV = 1.0f / 4294967296.0f;

constexpr size_t MiB = 1u << 20;
constexpr size_t WS_SSQ = 0;
constexpr size_t WS_BAR = 1 * MiB;
constexpr size_t WS_CARRY = 2 * MiB;
constexpr size_t WS_WQKV = 16 * MiB, WS_WO = 40 * MiB, WS_WIN = 56 * MiB, WS_WG = 88 * MiB, WS_WOUT = 92 * MiB, WS_WUP = 108 * MiB, WS_WDN = 300 * MiB;
constexpr size_t WS_XB = 400 * MiB, WS_QKV = 432 * MiB, WS_AO = 480 * MiB, WS_REC = 512 * MiB, WS_XC = 576 * MiB, WS_GA = 608 * MiB, WS_GU = 672 * MiB,
                 WS_HG = 736 * MiB, WS_P = 768 * MiB, WS_ACT = 960 * MiB, WS_END = 1056 * MiB;

constexpr int LDS_BYTES = 147456, MISC_OFF = 147200, NSTEPS = 32;
#ifndef DEFER_CONV
#define DEFER_CONV 1
#endif

__device__ __forceinline__ unsigned cvt_pk_bf16(float lo, float hi) { unsigned r; asm volatile("v_cvt_pk_bf16_f32 %0, %1, %2" : "=v"(r) : "v"(lo), "v"(hi)); return r; }
__device__ __forceinline__ float bflo(unsigned w) { return __uint_as_float(w << 16); }
__device__ __forceinline__ float bfhi(unsigned w) { return __uint_as_float(w & 0xffff0000u); }
__device__ __forceinline__ float gelu_tanh(float x) {
    const float z = 0.7978845608028654f * (x + 0.044715f * x * x * x);
    return x * __builtin_amdgcn_rcpf(1.0f + __builtin_amdgcn_exp2f(-2.0f * LOG2E * z));
}
__device__ __forceinline__ f32x2 gelu_tanh2(f32x2 x) {
    const f32x2 w = (x * x) * 0.044715f + 1.0f;
    const f32x2 t = (x * w) * (-2.0f * LOG2E * 0.7978845608028654f);
    f32x2 e; e.x = __builtin_amdgcn_exp2f(t.x); e.y = __builtin_amdgcn_exp2f(t.y);
    const f32x2 d = e + 1.0f;
    f32x2 r; r.x = __builtin_amdgcn_rcpf(d.x); r.y = __builtin_amdgcn_rcpf(d.y);
    return x * r;
}
__device__ __forceinline__ float sigmoidf_(float v) { return __builtin_amdgcn_rcpf(1.0f + __builtin_amdgcn_exp2f(-LOG2E * v)); }

namespace pg8 {
constexpr int BM = 256, BK = 64, HALF = 128, HTB = HALF * BK * 2, STAGE_BYTES = 8 * HTB, NXCD = 8, WGM = 8;
__host__ __device__ __forceinline__ int lds_byte(int r, int c) { const int st = (r >> 4) * 2 + (c >> 5), rr = r & 15, cc = c & 31, ob = rr * 64 + cc * 2; return st * 1024 + (ob ^ (((ob >> 9) & 1) << 5)); }
__host__ __device__ __forceinline__ void stage_rc(int b, int& R, int& C) { const int st = b / 1024, sb = b % 1024, swz = sb ^ (((sb >> 9) & 1) << 5); R = (st >> 1) * 16 + swz / 64; C = (st & 1) * 32 + (swz % 64) / 2; }
__host__ __device__ __forceinline__ int perm32(int rho) { const int n = rho >> 4, i = rho & 15; return 8 * (i >> 2) + 4 * n + (i & 3); }

struct Unit { int pm, pn; };
struct Gemm { const bf16_t* A; const bf16_t* Bt; int M, N, K, lda, ldb, agrp; };

struct StaticOrder {
    int nM, nN, nwg, G, c;
    __host__ __device__ void init(int M, int N, int G_, int c_) { nM = M / BM; nN = N / BM; nwg = nM * nN; G = G_; c = c_; }
    __host__ __device__ bool next(int i, Unit& u) const {
        const long L = (long)i * G + c; if (L >= nwg) return false;
        int wgid = (int)L; { const int q = nwg / NXCD, r = nwg % NXCD, xcd = wgid % NXCD, off = wgid / NXCD; wgid = (xcd < r ? xcd * (q + 1) : r * (q + 1) + (xcd - r) * q) + off; }
        const int nig = WGM * nN, gid = wgid / nig, fm = gid * WGM, gsz = (nM - fm) < WGM ? (nM - fm) : WGM;
        u.pm = fm + ((wgid % nig) % gsz); u.pn = (wgid % nig) / gsz; return true;
    }
};


struct EpiScaleBf16 {
    bf16_t* O; int ldc; const unsigned long long* ssq;
    __device__ __forceinline__ void operator()(const f32x4 (&acc)[2][2][4][2], const Unit& u, int wr, int wc, int fr, int fq) const {
        const int row0 = u.pm * BM + wr * 64 + fr, col0 = u.pn * BM + wc * 32 + 8 * fq;
#pragma unroll
        for (int ai = 0; ai < 2; ++ai)
#pragma unroll
            for (int m = 0; m < 4; ++m) {
                const int row = row0 + ai * HALF + m * 16;
                const float rs = ssq ? rsqrtf((float)ssq[row] * SSQ_INV * (1.0f / D) + EPS) : 1.0f;
                bf16_t* rowp = O + (size_t)row * ldc + col0;
#pragma unroll
                for (int bj = 0; bj < 2; ++bj) { const f32x4 v0 = acc[ai][bj][m][0] * rs, v1 = acc[ai][bj][m][1] * rs;
                    u32x4 w; w.x = cvt_pk_bf16(v0[0], v0[1]); w.y = cvt_pk_bf16(v0[2], v0[3]); w.z = cvt_pk_bf16(v1[0], v1[1]); w.w = cvt_pk_bf16(v1[2], v1[3]);
                    *(u32x4*)(rowp + bj * HALF) = w; } }
    }
};
struct EpiResid {
    const float* xold_f32; float* xnew_f32; bf16_t* xb; unsigned long long* ssq;
    __device__ __forceinline__ void finish_row(const f32x4 (&o)[2][2], int row, size_t off, int fq) const {
        float s = 0.f;
#pragma unroll
        for (int bj = 0; bj < 2; ++bj) { const f32x4 o0 = o[bj][0], o1 = o[bj][1];
            if (xnew_f32) { *(f32x4*)(xnew_f32 + off + bj * HALF) = o0; *(f32x4*)(xnew_f32 + off + bj * HALF + 4) = o1; }
            else *(u32x4*)(xb + off + bj * HALF) = (u32x4){cvt_pk_bf16(o0[0], o0[1]), cvt_pk_bf16(o0[2], o0[3]), cvt_pk_bf16(o1[0], o1[1]), cvt_pk_bf16(o1[2], o1[3])};
            const f32x4 q = o0 * o0 + o1 * o1; s += (q[0] + q[1]) + (q[2] + q[3]); }
        if (ssq) { s += __shfl_xor(s, 16); s += __shfl_xor(s, 32);
            if (fq == 0) __hip_atomic_fetch_add(ssq + row, (unsigned long long)(s * SSQ_SCALE), __ATOMIC_RELAXED, __HIP_MEMORY_SCOPE_AGENT); }
    }
    __device__ __forceinline__ void operator()(const f32x4 (&acc)[2][2][4][2], const Unit& u, int wr, int wc, int fr, int fq) const {
        const int row0 = u.pm * BM + wr * 64 + fr, col0 = u.pn * BM + wc * 32 + 8 * fq;
        if (xold_f32) {
#pragma unroll
            for (int ai = 0; ai < 2; ++ai)
#pragma unroll
                for (int m = 0; m < 4; ++m) {
                    const int row = row0 + ai * HALF + m * 16; const size_t off = (size_t)row * D + col0;
                    f32x4 o[2][2];
#pragma unroll
                    for (int bj = 0; bj < 2; ++bj) { o[bj][0] = *(const f32x4*)(xold_f32 + off + bj * HALF) + acc[ai][bj][m][0]; o[bj][1] = *(const f32x4*)(xold_f32 + off + bj * HALF + 4) + acc[ai][bj][m][1]; }
                    finish_row(o, row, off, fq);
                }
            return;
        }
        u32x4 xr[2][4][2];
#pragma unroll
        for (int ai = 0; ai < 2; ++ai)
#pragma unroll
            for (int m = 0; m < 4; ++m)
#pragma unroll
                for (int bj = 0; bj < 2; ++bj) xr[ai][m][bj] = *(const u32x4*)(xb + (size_t)(row0 + ai * HALF + m * 16) * D + col0 + bj * HALF);
#pragma unroll
        for (int ai = 0; ai < 2; ++ai)
#pragma unroll
            for (int m = 0; m < 4; ++m) {
                const int row = row0 + ai * HALF + m * 16; const size_t off = (size_t)row * D + col0;
                f32x4 o[2][2];
#pragma unroll
                for (int bj = 0; bj < 2; ++bj) { const u32x4 x = xr[ai][m][bj];
                    o[bj][0] = (f32x4){bflo(x.x), bfhi(x.x), bflo(x.y), bfhi(x.y)} + acc[ai][bj][m][0]; o[bj][1] = (f32x4){bflo(x.z), bfhi(x.z), bflo(x.w), bfhi(x.w)} + acc[ai][bj][m][1]; }
                finish_row(o, row, off, fq);
            }
    }
};
template <int CTRL> __device__ __forceinline__ float dppf(float old, float src) {
    return __int_as_float(__builtin_amdgcn_update_dpp(__float_as_int(old), __float_as_int(src), CTRL, 0xf, 0xf, false));
}
template <int CTRL> __device__ __forceinline__ float dpp0(float src) {
    return __int_as_float(__builtin_amdgcn_update_dpp(0, __float_as_int(src), CTRL, 0xf, 0xf, true));
}
template <int S> __device__ __forceinline__ float rowprev(float cur, float pb) {
    const float o = dppf<0x100 + 16 - S>(0.f, pb);
    return dppf<0x110 + S>(o, cur);
}
struct EpiConvAct {
    bf16_t* ACT; const unsigned long long* ssq; const float* cw; const float* cb; float* halo; LAS unsigned char* hl;
    __device__ __forceinline__ void operator()(f32x4 (&acc)[2][2][4][2], const Unit& u, int wr, int wc, int fr, int fq) const {
        const int row0 = u.pm * BM + wr * 64 + fr, tcol = wc * 32 + 8 * fq;
#pragma unroll
        for (int ai = 0; ai < 2; ++ai)
#pragma unroll
            for (int m = 0; m < 4; ++m) {
                const float rs = rsqrtf((float)ssq[row0 + ai * HALF + m * 16] * SSQ_INV * (1.0f / D) + EPS);
#pragma unroll
                for (int bj = 0; bj < 2; ++bj)
#pragma unroll
                    for (int n = 0; n < 2; ++n) acc[ai][bj][m][n] = acc[ai][bj][m][n] * rs; }
        if (fr >= 14) {
#pragma unroll
            for (int ai = 0; ai < 2; ++ai)
#pragma unroll
                for (int bj = 0; bj < 2; ++bj)
#pragma unroll
                    for (int n = 0; n < 2; ++n) *(LAS f32x4*)(hl + ((((2 * ai + wr) * 2 + (fr - 14)) * 256) + bj * HALF + tcol + 4 * n) * 4) = acc[ai][bj][3][n];
            if (wr == 1) {
#pragma unroll
                for (int bj = 0; bj < 2; ++bj)
#pragma unroll
                    for (int n = 0; n < 2; ++n) *(f32x4*)(halo + (size_t)(u.pm * 4 + 2 + fr - 14) * FF2 + u.pn * BM + bj * HALF + tcol + 4 * n) = acc[1][bj][3][n]; }
        }
        if (wr == 0 && fr < 2) {
#pragma unroll
            for (int bj = 0; bj < 2; ++bj)
#pragma unroll
                for (int n = 0; n < 2; ++n) *(f32x4*)(halo + (size_t)(u.pm * 4 + fr) * FF2 + u.pn * BM + bj * HALF + tcol + 4 * n) = acc[0][bj][0][n]; }
        asm volatile("s_waitcnt lgkmcnt(0)" ::: "memory"); __builtin_amdgcn_s_barrier(); asm volatile("" ::: "memory");
        const int ch0 = u.pn * HALF + tcol;
        u32x2 pk[2][4][2];
#pragma unroll
        for (int n = 0; n < 2; ++n) {
            const float* cwp = cw + ch0 + 4 * n;
            const f32x4 wg0 = *(const f32x4*)(cwp), wg1 = *(const f32x4*)(cwp + FF2), wg2 = *(const f32x4*)(cwp + 2 * FF2), bg = *(const f32x4*)(cb + ch0 + 4 * n);
            const f32x4 wv0 = *(const f32x4*)(cwp + FF), wv1 = *(const f32x4*)(cwp + FF2 + FF), wv2 = *(const f32x4*)(cwp + 2 * FF2 + FF), bv = *(const f32x4*)(cb + FF + ch0 + 4 * n);
#pragma unroll
            for (int ai = 0; ai < 2; ++ai) {
                const int q = 2 * ai + wr;
                f32x4 pg = {0.f, 0.f, 0.f, 0.f}, pv = {0.f, 0.f, 0.f, 0.f};
                if (q > 0 && fr >= 14) { pg = *(const LAS f32x4*)(hl + ((((q - 1) * 2 + (fr - 14)) * 256) + tcol + 4 * n) * 4); pv = *(const LAS f32x4*)(hl + ((((q - 1) * 2 + (fr - 14)) * 256) + HALF + tcol + 4 * n) * 4); }
#pragma unroll
                for (int m = 0; m < 4; ++m) {
                    const f32x4 cg = acc[ai][0][m][n], cv = acc[ai][1][m][n];
                    const f32x4 gp = m > 0 ? acc[ai][0][m > 0 ? m - 1 : 0][n] : pg, vp = m > 0 ? acc[ai][1][m > 0 ? m - 1 : 0][n] : pv;
                    float ugv[4], uvv[4];
                    const f32x4 ug4 = wg2 * cg + bg, uv4 = wv2 * cv + bv;
#pragma unroll
                    for (int e = 0; e < 4; ++e) {
                        float ug = ug4[e], uv = uv4[e];
                        asm("v_fmac_f32_dpp %0, %1, %2 row_shr:1 row_mask:0xf bank_mask:0xf\n\tv_fmac_f32_dpp %0, %3, %2 row_shl:15 row_mask:0xf bank_mask:0xf" : "+v"(ug) : "v"(cg[e]), "v"(wg1[e]), "v"(gp[e]));
                        asm("v_fmac_f32_dpp %0, %1, %2 row_shr:2 row_mask:0xf bank_mask:0xf\n\tv_fmac_f32_dpp %0, %3, %2 row_shl:14 row_mask:0xf bank_mask:0xf" : "+v"(ug) : "v"(cg[e]), "v"(wg0[e]), "v"(gp[e]));
                        asm("v_fmac_f32_dpp %0, %1, %2 row_shr:1 row_mask:0xf bank_mask:0xf\n\tv_fmac_f32_dpp %0, %3, %2 row_shl:15 row_mask:0xf bank_mask:0xf" : "+v"(uv) : "v"(cv[e]), "v"(wv1[e]), "v"(vp[e]));
                        asm("v_fmac_f32_dpp %0, %1, %2 row_shr:2 row_mask:0xf bank_mask:0xf\n\tv_fmac_f32_dpp %0, %3, %2 row_shl:14 row_mask:0xf bank_mask:0xf" : "+v"(uv) : "v"(cv[e]), "v"(wv0[e]), "v"(vp[e]));
                        ugv[e] = ug; uvv[e] = uv; }
                    const f32x2 o01 = gelu_tanh2((f32x2){ugv[0], ugv[1]}) * (f32x2){uvv[0], uvv[1]}, o23 = gelu_tanh2((f32x2){ugv[2], ugv[3]}) * (f32x2){uvv[2], uvv[3]};

                    pk[ai][m][n] = (u32x2){cvt_pk_bf16(o01.x, o01.y), cvt_pk_bf16(o23.x, o23.y)};
                }
            }
        }
#pragma unroll
        for (int ai = 0; ai < 2; ++ai)
#pragma unroll
            for (int m = 0; m < 4; ++m)
                *(u32x4*)(ACT + (size_t)(row0 + ai * HALF + m * 16) * FF + ch0) = (u32x4){pk[ai][m][0].x, pk[ai][m][0].y, pk[ai][m][1].x, pk[ai][m][1].y};
    }
};
__device__ __forceinline__ float dpp_shr1_keep(float old, float src) { return __int_as_float(__builtin_amdgcn_update_dpp(__float_as_int(old), __float_as_int(src), 0x111, 0xf, 0xf, false)); }
__device__ __forceinline__ void conv3_rows(const f32x4& x0, const f32x4& x1, const f32x4& x2, const f32x4& x3, const f32x4& p2, const f32x4& p3,
                                           const f32x4& w0, const f32x4& w1, const f32x4& w2, const f32x4& b, f32x4 (&u)[4]) {
    f32x4 t3, t2;
#pragma unroll
    for (int e = 0; e < 4; ++e) { t3[e] = dpp_shr1_keep(p3[e], x3[e]); t2[e] = dpp_shr1_keep(p2[e], x2[e]); }
    u[0] = w2 * x0 + b; u[0] = w1 * t3 + u[0]; u[0] = w0 * t2 + u[0];
    u[1] = w2 * x1 + b; u[1] = w1 * x0 + u[1]; u[1] = w0 * t3 + u[1];
    u[2] = w2 * x2 + b; u[2] = w1 * x1 + u[2]; u[2] = w0 * x0 + u[2];
    u[3] = w2 * x3 + b; u[3] = w1 * x2 + u[3]; u[3] = w0 * x1 + u[3];
}
struct EpiConvActP {
    bf16_t* ACT; const unsigned long long* ssq; const float* cw; const float* cb; float* halo; LAS unsigned char* hl;
    __device__ __forceinline__ void operator()(f32x4 (&acc)[2][2][4][2], const Unit& u, int wr, int wc, int fr, int fq) const {
        const int rowb = u.pm * BM + wr * 64 + 4 * fr, tcol = wc * 32 + 8 * fq;
#pragma unroll
        for (int ai = 0; ai < 2; ++ai)
#pragma unroll
            for (int m = 0; m < 4; ++m) {
                const float rs = rsqrtf((float)ssq[rowb + ai * HALF + m] * SSQ_INV * (1.0f / D) + EPS);
#pragma unroll
                for (int bj = 0; bj < 2; ++bj)
#pragma unroll
                    for (int n = 0; n < 2; ++n) acc[ai][bj][m][n] = acc[ai][bj][m][n] * rs; }
        if (fr == 15) {
#pragma unroll
            for (int ai = 0; ai < 2; ++ai)
#pragma unroll
                for (int bj = 0; bj < 2; ++bj)
#pragma unroll
                    for (int n = 0; n < 2; ++n) { LAS unsigned char* hp = hl + ((((2 * ai + wr) * 2) * 256) + bj * HALF + tcol + 4 * n) * 4;
                        *(LAS f32x4*)(hp) = acc[ai][bj][2][n]; *(LAS f32x4*)(hp + 1024) = acc[ai][bj][3][n]; }
            if (wr == 1) {
#pragma unroll
                for (int bj = 0; bj < 2; ++bj)
#pragma unroll
                    for (int n = 0; n < 2; ++n) { float* gp = halo + (size_t)(u.pm * 4 + 2) * FF2 + u.pn * BM + bj * HALF + tcol + 4 * n;
                        *(f32x4*)(gp) = acc[1][bj][2][n]; *(f32x4*)(gp + FF2) = acc[1][bj][3][n]; } }
        }
        if (wr == 0 && fr == 0) {
#pragma unroll
            for (int bj = 0; bj < 2; ++bj)
#pragma unroll
                for (int n = 0; n < 2; ++n) { float* gp = halo + (size_t)(u.pm * 4) * FF2 + u.pn * BM + bj * HALF + tcol + 4 * n;
                    *(f32x4*)(gp) = acc[0][bj][0][n]; *(f32x4*)(gp + FF2) = acc[0][bj][1][n]; } }
        asm volatile("s_waitcnt lgkmcnt(0)" ::: "memory"); __builtin_amdgcn_s_barrier(); asm volatile("" ::: "memory");
        const int ch0 = u.pn * HALF + tcol;
        u32x2 pk[2][4][2];
#pragma unroll
        for (int n = 0; n < 2; ++n) {
            const float* cwp = cw + ch0 + 4 * n;
            const f32x4 wg0 = *(const f32x4*)(cwp), wg1 = *(const f32x4*)(cwp + FF2), wg2 = *(const f32x4*)(cwp + 2 * FF2), bg = *(const f32x4*)(cb + ch0 + 4 * n);
            const f32x4 wv0 = *(const f32x4*)(cwp + FF), wv1 = *(const f32x4*)(cwp + FF2 + FF), wv2 = *(const f32x4*)(cwp + 2 * FF2 + FF), bv = *(const f32x4*)(cb + FF + ch0 + 4 * n);
#pragma unroll
            for (int ai = 0; ai < 2; ++ai) {
                const int q = 2 * ai + wr;
                f32x4 pg2 = {0.f, 0.f, 0.f, 0.f}, pg3 = pg2, pv2 = pg2, pv3 = pg2;
                if (q > 0 && fr == 0) { const LAS unsigned char* hp = hl + ((((q - 1) * 2) * 256) + tcol + 4 * n) * 4;
                    pg2 = *(const LAS f32x4*)(hp); pg3 = *(const LAS f32x4*)(hp + 1024); pv2 = *(const LAS f32x4*)(hp + HALF * 4); pv3 = *(const LAS f32x4*)(hp + 1024 + HALF * 4); }
                f32x4 ug[4], uv[4];
                conv3_rows(acc[ai][0][0][n], acc[ai][0][1][n], acc[ai][0][2][n], acc[ai][0][3][n], pg2, pg3, wg0, wg1, wg2, bg, ug);
                conv3_rows(acc[ai][1][0][n], acc[ai][1][1][n], acc[ai][1][2][n], acc[ai][1][3][n], pv2, pv3, wv0, wv1, wv2, bv, uv);
#pragma unroll
                for (int m = 0; m < 4; ++m) {
                    const f32x2 o01 = gelu_tanh2((f32x2){ug[m][0], ug[m][1]}) * (f32x2){uv[m][0], uv[m][1]}, o23 = gelu_tanh2((f32x2){ug[m][2], ug[m][3]}) * (f32x2){uv[m][2], uv[m][3]};
                    pk[ai][m][n] = (u32x2){cvt_pk_bf16(o01.x, o01.y), cvt_pk_bf16(o23.x, o23.y)};
                }
            }
        }
#pragma unroll
        for (int ai = 0; ai < 2; ++ai)
#pragma unroll
            for (int m = 0; m < 4; ++m)
                *(u32x4*)(ACT + (size_t)(rowb + ai * HALF + m) * FF + ch0) = (u32x4){pk[ai][m][0].x, pk[ai][m][0].y, pk[ai][m][1].x, pk[ai][m][1].y};
    }
};
template <class Epi, bool ALIGN_EPI, bool APERM = false>
__device__ __forceinline__ void gemm_phase(LAS unsigned char* lds, const Gemm g, const StaticOrder& S, const Epi& E) {
    int tid = threadIdx.x; asm volatile("" : "+v"(tid));
    const int wid = __builtin_amdgcn_readfirstlane(tid >> 6), lane = tid & 63, wr = wid >> 2, wc = wid & 3, fr = lane & 15, fq = lane >> 4;
    const int nt = g.K / BK;
    unsigned voffA[2], voffB[2];
#pragma unroll
    for (int i = 0; i < 2; ++i) { int R, C; stage_rc(tid * 16 + i * 8192, R, C); const int Rb = (R & ~31) + perm32(R & 31);
        const int Ra = APERM ? ((R & 64) + 4 * (R & 15) + ((R >> 4) & 3)) : R;
        voffA[i] = (unsigned)(Ra * g.lda + C) * 2u; voffB[i] = (unsigned)(Rb * g.ldb + C) * 2u; }
    const size_t kstep = (size_t)(BK * 2);
    const size_t hstepA = (size_t)HALF * g.lda * 2, hstepB = (size_t)HALF * g.ldb * 2;
    const size_t tstepA = 2 * hstepA, tstepB = 2 * hstepB;
    const unsigned ldsw = (unsigned)wid * 1024u;
    const int aoff = lds_byte(wr * 64 + fr, fq * 8), boff = lds_byte(wc * 32 + fr, fq * 8);
#define PG8_SA(b, h) (((b) * 2 + (h)) * HTB)
#define PG8_SB(b, h) ((4 + (b) * 2 + (h)) * HTB)
#define PG8_STAGE(bufoff, gbase, voff) do { _Pragma("unroll") for (int _i = 0; _i < 2; ++_i) \
        __builtin_amdgcn_global_load_lds((const unsigned*)((const char*)(gbase) + (voff)[_i]), (LAS unsigned*)(lds + (bufoff) + ldsw + _i * 8192), 16, 0, 0); } while (0)
#define PG8_LDA(dst, b, h) do { _Pragma("unroll") for (int m = 0; m < 4; ++m) _Pragma("unroll") for (int k = 0; k < 2; ++k) dst[m][k] = *(const LAS bf16x8*)(lds + PG8_SA(b, h) + aoff + m * 2048 + k * 1024); } while (0)
#define PG8_LDB(dst, b, h) do { _Pragma("unroll") for (int n = 0; n < 2; ++n) _Pragma("unroll") for (int k = 0; k < 2; ++k) dst[n][k] = *(const LAS bf16x8*)(lds + PG8_SB(b, h) + boff + n * 2048 + k * 1024); } while (0)
#define PG8_MMA(ai, bj, At, Bt) do { __builtin_amdgcn_s_setprio(1); _Pragma("unroll") for (int m = 0; m < 4; ++m) _Pragma("unroll") for (int n = 0; n < 2; ++n) _Pragma("unroll") for (int k = 0; k < 2; ++k) \
        acc[ai][bj][m][n] = __builtin_amdgcn_mfma_f32_16x16x32_bf16(Bt[n][k], At[m][k], acc[ai][bj][m][n], 0, 0, 0); __builtin_amdgcn_s_setprio(0); } while (0)
#define PG8_WAIT_V(n) asm volatile("s_waitcnt vmcnt(" #n ")" ::: "memory")
#define PG8_WAIT_L(n) asm volatile("s_waitcnt lgkmcnt(" #n ")" ::: "memory")
#define PG8_BAR __builtin_amdgcn_s_barrier()
#define PG8_SCHED __builtin_amdgcn_sched_barrier(0)
    Unit cur, nxt; int ui = 0;
    if (!S.next(0, cur)) return;
    f32x4 acc[2][2][4][2];
#pragma unroll
    for (int a = 0; a < 2; ++a)
#pragma unroll
        for (int b = 0; b < 2; ++b)
#pragma unroll
            for (int m = 0; m < 4; ++m)
#pragma unroll
                for (int n = 0; n < 2; ++n) acc[a][b][m][n] = (f32x4){0.f, 0.f, 0.f, 0.f};
    bf16x8 At[4][2], B0[2][2], B1[2][2];
    const char* cA = (const char*)g.A + (size_t)cur.pm * tstepA + (size_t)(cur.pn >> 1) * g.agrp; const char* cB = (const char*)g.Bt + (size_t)cur.pn * tstepB;
    PG8_STAGE(PG8_SB(0, 0), cB, voffB); PG8_STAGE(PG8_SB(0, 1), cB + hstepB, voffB); PG8_STAGE(PG8_SA(0, 0), cA, voffA); PG8_STAGE(PG8_SA(0, 1), cA + hstepA, voffA);
    if (wr == 1) PG8_BAR;
    PG8_WAIT_V(2); PG8_BAR;
    PG8_STAGE(PG8_SB(1, 0), cB + kstep, voffB); PG8_STAGE(PG8_SA(1, 0), cA + kstep, voffA); PG8_STAGE(PG8_SB(1, 1), cB + hstepB + kstep, voffB);
    PG8_WAIT_V(6); PG8_BAR;
    for (;;) {
        const bool has_next = S.next(ui + 1, nxt);
        const char* nA = has_next ? (const char*)g.A + (size_t)nxt.pm * tstepA + (size_t)(nxt.pn >> 1) * g.agrp : cA; const char* nB = has_next ? (const char*)g.Bt + (size_t)nxt.pn * tstepB : cB;
        for (int t = 0; t < nt; t += 2) {
            const bool last = (t == nt - 2);
            const char* a1 = cA + (size_t)(t + 1) * kstep;
            const char* a2 = last ? nA : cA + (size_t)(t + 2) * kstep; const char* b2 = last ? nB : cB + (size_t)(t + 2) * kstep;
            const char* a3 = a2 + kstep; const char* b3 = b2 + kstep;
            PG8_LDB(B0, 0, 0); PG8_LDB(B1, 0, 1); PG8_SCHED; PG8_LDA(At, 0, 0); PG8_STAGE(PG8_SA(1, 1), a1 + hstepA, voffA);
            PG8_WAIT_V(8); PG8_WAIT_L(0); PG8_BAR; PG8_MMA(0, 0, At, B0); PG8_MMA(0, 1, At, B1); PG8_BAR; PG8_SCHED;
            PG8_LDA(At, 0, 1); PG8_STAGE(PG8_SB(0, 0), b2, voffB); PG8_STAGE(PG8_SB(0, 1), b2 + hstepB, voffB); PG8_STAGE(PG8_SA(0, 0), a2, voffA);
            PG8_WAIT_V(8); PG8_WAIT_L(0); PG8_BAR; PG8_MMA(1, 0, At, B0); PG8_MMA(1, 1, At, B1); PG8_BAR; PG8_SCHED;
            PG8_LDB(B0, 1, 0); PG8_LDB(B1, 1, 1); PG8_SCHED; PG8_LDA(At, 1, 0); PG8_STAGE(PG8_SA(0, 1), a2 + hstepA, voffA);
            PG8_WAIT_V(8); PG8_WAIT_L(0); PG8_BAR; PG8_MMA(0, 0, At, B0); PG8_MMA(0, 1, At, B1); PG8_BAR; PG8_SCHED;
            PG8_LDA(At, 1, 1); PG8_STAGE(PG8_SB(1, 0), b3, voffB); PG8_STAGE(PG8_SB(1, 1), b3 + hstepB, voffB); PG8_STAGE(PG8_SA(1, 0), a3, voffA);
            PG8_WAIT_V(8); PG8_WAIT_L(0); PG8_BAR; PG8_MMA(1, 0, At, B0); PG8_MMA(1, 1, At, B1); PG8_BAR; PG8_SCHED;
        }
        if constexpr (ALIGN_EPI) { if (wr == 0) PG8_BAR; }
        E(acc, cur, wr, wc, fr, fq);
        if (!has_next) break;
#pragma unroll
        for (int a = 0; a < 2; ++a)
#pragma unroll
            for (int b = 0; b < 2; ++b)
#pragma unroll
                for (int m = 0; m < 4; ++m)
#pragma unroll
                    for (int n = 0; n < 2; ++n) acc[a][b][m][n] = (f32x4){0.f, 0.f, 0.f, 0.f};
        cur = nxt; cA = nA; cB = nB; ++ui;
        if constexpr (ALIGN_EPI) { if (wr == 1) PG8_BAR; }
    }
    PG8_WAIT_V(0);
    if constexpr (!ALIGN_EPI) { if (wr == 0) PG8_BAR; }
    PG8_BAR;
#undef PG8_SA
#undef PG8_SB
#undef PG8_STAGE
#undef PG8_LDA
#undef PG8_LDB
#undef PG8_MMA
#undef PG8_WAIT_V
#undef PG8_WAIT_L
#undef PG8_BAR
#undef PG8_SCHED
}
}

struct Args { const float* in[21]; float* out; unsigned char* ws; };
enum { I_X = 0, I_MIXN, I_FFNN, I_WQKV, I_QG, I_KG, I_SINK, I_WO, I_WIN, I_RCW, I_RCB, I_WA, I_BA, I_WI, I_BI, I_LAM, I_WOUT, I_WUP, I_FCW, I_FCB, I_WDN };

__device__ __forceinline__ float wave_sum(float v) {
#pragma unroll
    for (int o = 1; o < 64; o <<= 1) v += __shfl_xor(v, o);
    return v;
}

struct TDesc { const float* W; const float* gain; bf16_t* O; int ldw, ldt; };
__device__ __forceinline__ void titem_load(const TDesc& d, f32x4 (&v)[16], f32x4 (&g)[4], int lane) {
    const int lr = lane >> 4, ln = lane & 15;
    const float* wp = d.W + (size_t)(4 * lr) * d.ldw + 4 * ln;
#pragma unroll
    for (int i = 0; i < 16; ++i) v[i] = *(const f32x4*)(wp + (size_t)(16 * (i >> 2) + (i & 3)) * d.ldw);
#pragma unroll
    for (int b = 0; b < 4; ++b) g[b] = d.gain ? *(const f32x4*)(d.gain + 16 * b + 4 * lr) : (f32x4){1.f, 1.f, 1.f, 1.f};
}
__device__ __forceinline__ void titem_store(const TDesc& d, const f32x4 (&v)[16], const f32x4 (&g)[4], LAS unsigned char* scr, int lane) {
    const int lr = lane >> 4, ln = lane & 15;
#pragma unroll
    for (int b = 0; b < 4; ++b)
#pragma unroll
        for (int e = 0; e < 4; ++e) {
            u32x2 w; w.x = cvt_pk_bf16(v[4 * b + 0][e] * g[b][0], v[4 * b + 1][e] * g[b][1]); w.y = cvt_pk_bf16(v[4 * b + 2][e] * g[b][2], v[4 * b + 3][e] * g[b][3]);
            *(LAS u32x2*)(scr + (4 * ln + e) * 136 + (16 * b + 4 * lr) * 2) = w; }
    asm volatile("s_waitcnt lgkmcnt(0)" ::: "memory");
    const int rn = lane >> 3, c = lane & 7;
#pragma unroll
    for (int j = 0; j < 8; ++j) { const int n = 8 * j + rn;
        const u32x2 lo = *(const LAS u32x2*)(scr + n * 136 + 16 * c), hi = *(const LAS u32x2*)(scr + n * 136 + 16 * c + 8);
        *(u32x4*)(d.O + (size_t)n * d.ldt + 8 * c) = (u32x4){lo.x, lo.y, hi.x, hi.y}; }
    asm volatile("s_waitcnt lgkmcnt(0)" ::: "memory");
}

struct Job { const float* W; const float* gain; bf16_t* WT; int ldw, ldt, K, N, gate_which; };
__device__ __forceinline__ Job get_job(const Args& a, int jb) {
    Job J; J.gain = nullptr; J.gate_which = -1; unsigned char* ws = a.ws;
    int kind, idx;
    if (jb < 8) { const int j = jb >> 2, l = 2 * j; kind = jb & 3; idx = (kind == 0 || kind == 3) ? j : l; }
    else { const int r = (jb - 8) % 20, j = (jb - 8) / 20, l = 2 * j + 1;
        if (r < 4) { kind = r == 0 ? 4 : r == 1 ? 5 : r == 2 ? 1 : 2; idx = (r < 2) ? j : l; } else { kind = 6; idx = j * 16 + (r - 4); } }
    if (kind == 0) { J.W = a.in[I_WQKV] + (size_t)idx * D * QKVD; J.gain = a.in[I_MIXN] + (size_t)(2 * idx) * D; J.WT = (bf16_t*)(ws + WS_WQKV) + (size_t)idx * QKVD * D; J.ldw = QKVD; J.ldt = D; J.K = D; J.N = QKVD; }
    else if (kind == 1) { J.W = a.in[I_WUP] + (size_t)idx * D * FF2; J.gain = a.in[I_FFNN] + (size_t)idx * D; J.WT = (bf16_t*)(ws + WS_WUP) + (size_t)idx * FF2 * D; J.ldw = FF2; J.ldt = D; J.K = D; J.N = FF2; J.gate_which = 2; }
    else if (kind == 2) { J.W = a.in[I_WDN] + (size_t)idx * FF * D; J.WT = (bf16_t*)(ws + WS_WDN) + (size_t)idx * D * FF; J.ldw = D; J.ldt = FF; J.K = FF; J.N = D; }
    else if (kind == 3) { J.W = a.in[I_WO] + (size_t)idx * D * D; J.WT = (bf16_t*)(ws + WS_WO) + (size_t)idx * D * D; J.ldw = D; J.ldt = D; J.K = D; J.N = D; }
    else if (kind == 4) { J.W = a.in[I_WIN] + (size_t)idx * D * 2 * D; J.gain = a.in[I_MIXN] + (size_t)(2 * idx + 1) * D; J.WT = (bf16_t*)(ws + WS_WIN) + (size_t)idx * 2 * D * D; J.ldw = 2 * D; J.ldt = D; J.K = D; J.N = 2 * D; }
    else if (kind == 5) { J.W = a.in[I_WOUT] + (size_t)idx * D * D; J.WT = (bf16_t*)(ws + WS_WOUT) + (size_t)idx * D * D; J.ldw = D; J.ldt = D; J.K = D; J.N = D; }
    else { const int j = idx >> 4, which = (idx >> 3) & 1, h = idx & 7;
      J.W = a.in[which ? I_WI : I_WA] + ((size_t)j * 8 + h) * 256 * 256; J.WT = (bf16_t*)(ws + WS_WG) + (size_t)j * 4096 * 256 + (size_t)h * 512 * 256;
      J.ldw = 256; J.ldt = 256; J.K = 256; J.N = 256; J.gate_which = which; }
    return J;
}

struct TIter {
    const Args* a; int jb, jb1, gw, NGW, base, it, nit, nN; Job J;
    __device__ __forceinline__ void open() { J = get_job(*a, jb); nN = J.N / 64; nit = (J.K / 64) * nN; int first = (gw - base) % NGW; if (first < 0) first += NGW; it = first; }
    __device__ __forceinline__ bool next(TDesc& d) {
        while (jb < jb1) {
            if (it < nit) {
                const int kb = it / nN, nb = it % nN, k0 = 64 * kb, n0 = 64 * nb; int orow0 = n0;
                if (J.gate_which == 2) { const int ch = n0 < FF ? n0 : n0 - FF; orow0 = 256 * (ch >> 7) + (n0 < FF ? 0 : 128) + (ch & 127); }
                else if (J.gate_which >= 0) orow0 = 256 * (n0 >> 7) + 128 * J.gate_which + (n0 & 127);
                d.W = J.W + (size_t)k0 * J.ldw + n0; d.gain = J.gain ? J.gain + k0 : nullptr; d.O = J.WT + (size_t)orow0 * J.ldt + k0; d.ldw = J.ldw; d.ldt = J.ldt;
                it += NGW; return true; }
            base = (base + nit) % NGW; ++jb; if (jb < jb1) open();
        }
        return false;
    }
};
__device__ __forceinline__ void convert_jobs(const Args& a, LAS unsigned char* lds, int jb0, int jb1, int worker_wg, int n_wg) {
    int tid = threadIdx.x; asm volatile("" : "+v"(tid));
    const int lane = tid & 63, wave = __builtin_amdgcn_readfirstlane(tid >> 6);
    LAS unsigned char* scr = lds + wave * 8704;
    TIter itr; itr.a = &a; itr.jb = jb0; itr.jb1 = jb1; itr.gw = worker_wg * 8 + wave; itr.NGW = n_wg * 8; itr.base = 0;
    if (jb0 >= jb1) return;
    itr.open();
    TDesc dA, dB; f32x4 vA[16], vB[16], gA[4], gB[4];
    bool hA = itr.next(dA); if (hA) titem_load(dA, vA, gA, lane);
    while (hA) {
        const bool hB = itr.next(dB); if (hB) titem_load(dB, vB, gB, lane);
        titem_store(dA, vA, gA, scr, lane);
        if (!hB) break;
        hA = itr.next(dA); if (hA) titem_load(dA, vA, gA, lane);
        titem_store(dB, vB, gB, scr, lane);
    }
}

__device__ __forceinline__ void prologue(const Args& a, LAS unsigned char* lds, int vcu, int G) {
    const int tid = threadIdx.x, lane = tid & 63, wave = __builtin_amdgcn_readfirstlane(tid >> 6);
    const int gw = vcu * 8 + wave, NGW = G * 8;
    {
        const float* x = a.in[I_X]; bf16_t* XB = (bf16_t*)(a.ws + WS_XB); unsigned long long* SSQ = (unsigned long long*)(a.ws + WS_SSQ);
        for (int m = gw; m < T; m += NGW) {
            const f32x4* xr = (const f32x4*)(x + (size_t)m * D) + lane; float s = 0.f;
            unsigned long long* o8 = (unsigned long long*)(XB + (size_t)m * D) + lane;
#pragma unroll
            for (int j = 0; j < 8; ++j) { const f32x4 v = xr[64 * j]; s += (v[0] * v[0] + v[1] * v[1]) + (v[2] * v[2] + v[3] * v[3]);
                o8[64 * j] = (unsigned long long)cvt_pk_bf16(v[0], v[1]) | ((unsigned long long)cvt_pk_bf16(v[2], v[3]) << 32); }
            s = wave_sum(s);
            if (lane < 8) SSQ[(size_t)lane * T + m] = lane == 0 ? (unsigned long long)(s * SSQ_SCALE) : 0ull;
        }
    }
    convert_jobs(a, lds, 0, DEFER_CONV ? 8 : 48, vcu, G);
}

__device__ __forceinline__ void ffn_fix_phase(const float* __restrict__ halo, const float* __restrict__ cw, const float* __restrict__ cb, bf16_t* __restrict__ ACT, int vcu, int G) {
    int tid = threadIdx.x; asm volatile("" : "+v"(tid)); const int gtid = vcu * 512 + tid, GT = G * 512;
    constexpr int NQ = FF / 4, NTASK = 32 * 2 * NQ;
    for (int task = gtid; task < NTASK; task += GT) {
        const int cq = task % NQ, r = (task / NQ) & 1, pm = task / (2 * NQ), c0 = cq * 4, tc = (c0 >> 7) * 256 + (c0 & 127);
        const f32x4 z = {0.f, 0.f, 0.f, 0.f};
        const float* h0 = halo + (size_t)(pm * 4) * FF2 + tc; const float* hp = halo + (size_t)(pm * 4 - 4) * FF2 + tc;
        const f32x4 g0 = *(const f32x4*)(h0 + (size_t)r * FF2), v0 = *(const f32x4*)(h0 + (size_t)r * FF2 + 128);
        f32x4 g1, v1, g2, v2;
        if (r == 1) { g1 = *(const f32x4*)(h0); v1 = *(const f32x4*)(h0 + 128); if (pm > 0) { g2 = *(const f32x4*)(hp + 3 * (size_t)FF2); v2 = *(const f32x4*)(hp + 3 * (size_t)FF2 + 128); } else { g2 = z; v2 = z; } }
        else if (pm > 0) { g1 = *(const f32x4*)(hp + 3 * (size_t)FF2); v1 = *(const f32x4*)(hp + 3 * (size_t)FF2 + 128); g2 = *(const f32x4*)(hp + 2 * (size_t)FF2); v2 = *(const f32x4*)(hp + 2 * (size_t)FF2 + 128); }
        else { g1 = z; v1 = z; g2 = z; v2 = z; }
        const f32x4 wg0 = *(const f32x4*)(cw + c0), wg1 = *(const f32x4*)(cw + FF2 + c0), wg2 = *(const f32x4*)(cw + 2 * FF2 + c0), bg = *(const f32x4*)(cb + c0);
        const f32x4 wv0 = *(const f32x4*)(cw + FF + c0), wv1 = *(const f32x4*)(cw + FF2 + FF + c0), wv2 = *(const f32x4*)(cw + 2 * FF2 + FF + c0), bv = *(const f32x4*)(cb + FF + c0);
        float o[4];
#pragma unroll
        for (int e = 0; e < 4; ++e) { const float ug = bg[e] + wg0[e] * g2[e] + wg1[e] * g1[e] + wg2[e] * g0[e], uv = bv[e] + wv0[e] * v2[e] + wv1[e] * v1[e] + wv2[e] * v0[e]; o[e] = gelu_tanh(ug) * uv; }
        *(u32x2*)(ACT + (size_t)(pm * 256 + r) * FF + c0) = (u32x2){cvt_pk_bf16(o[0], o[1]), cvt_pk_bf16(o[2], o[3])};
    }
}

__device__ __forceinline__ void rec_conv_phase(const bf16_t* __restrict__ REC, const float* __restrict__ cw, const float* __restrict__ cb, bf16_t* __restrict__ XC, int vcu, int G) {
    int tid = threadIdx.x; asm volatile("" : "+v"(tid)); const int gtid = vcu * 512 + tid, GT = G * 512;
    constexpr int NCG = D / 8, NTASK = (T / 16) * NCG;
    for (int task = gtid; task < NTASK; task += GT) {
        const int cgp = task % NCG, rc = task / NCG, c0 = cgp * 8, t0 = rc * 16;
        float w[4][8], b[8];
#pragma unroll
        for (int k = 0; k < 4; ++k) { const f32x4 a0 = *(const f32x4*)(cw + (size_t)k * D + c0), a1 = *(const f32x4*)(cw + (size_t)k * D + c0 + 4);
#pragma unroll
            for (int e = 0; e < 4; ++e) { w[k][e] = a0[e]; w[k][4 + e] = a1[e]; } }
        { const f32x4 a0 = *(const f32x4*)(cb + c0), a1 = *(const f32x4*)(cb + c0 + 4);
#pragma unroll
            for (int e = 0; e < 4; ++e) { b[e] = a0[e]; b[4 + e] = a1[e]; } }
        float x3[8], x2[8], x1[8];
#pragma unroll
        for (int e = 0; e < 8; ++e) { x3[e] = 0.f; x2[e] = 0.f; x1[e] = 0.f; }
        if (t0 > 0) {
            const u32x4 ra = *(const u32x4*)(REC + (size_t)(t0 - 3) * 2 * D + c0), rb = *(const u32x4*)(REC + (size_t)(t0 - 2) * 2 * D + c0), rc2 = *(const u32x4*)(REC + (size_t)(t0 - 1) * 2 * D + c0);
#pragma unroll
            for (int e = 0; e < 4; ++e) { x3[2 * e] = bflo(ra[e]); x3[2 * e + 1] = bfhi(ra[e]); x2[2 * e] = bflo(rb[e]); x2[2 * e + 1] = bfhi(rb[e]); x1[2 * e] = bflo(rc2[e]); x1[2 * e + 1] = bfhi(rc2[e]); }
        }
        u32x4 rrow[16];
#pragma unroll
        for (int r = 0; r < 16; ++r) rrow[r] = *(const u32x4*)(REC + (size_t)(t0 + r) * 2 * D + c0);
#pragma unroll
        for (int r = 0; r < 16; ++r) {
            const int t = t0 + r;
            const u32x4 rr = rrow[r];
            float x0[8], o[8];
#pragma unroll
            for (int e = 0; e < 4; ++e) { x0[2 * e] = bflo(rr[e]); x0[2 * e + 1] = bfhi(rr[e]); }
#pragma unroll
            for (int e = 0; e < 8; ++e) { o[e] = b[e] + w[0][e] * x3[e] + w[1][e] * x2[e] + w[2][e] * x1[e] + w[3][e] * x0[e]; x3[e] = x2[e]; x2[e] = x1[e]; x1[e] = x0[e]; }
            u32x4 wv; wv.x = cvt_pk_bf16(o[0], o[1]); wv.y = cvt_pk_bf16(o[2], o[3]); wv.z = cvt_pk_bf16(o[4], o[5]); wv.w = cvt_pk_bf16(o[6], o[7]);
            *(u32x4*)(XC + (size_t)t * D + c0) = wv;
        }
    }
}

__device__ __forceinline__ float bfe(const u32x4& v, int e) { const unsigned w = v[e >> 1]; return (e & 1) ? bfhi(w) : bflo(w); }
__device__ __forceinline__ void scan1_phase(const bf16_t* __restrict__ GP, const bf16_t* __restrict__ XC, const float* __restrict__ ba, const float* __restrict__ bi, const float* __restrict__ lam, bf16_t* __restrict__ LB, bf16_t* __restrict__ UB, float* __restrict__ E, float* __restrict__ AP, int blk, int G) {
    int tid = threadIdx.x; asm volatile("" : "+v"(tid));
    for (int unit = blk; unit < 256; unit += G) {
        const int sc = unit * 2 + (tid >> 8), ch = (tid & 255) * 8, gcol = (ch >> 7) * 256 + (ch & 127);
        float vba[8], vbi[8], vsp[8];
        { const f32x4 a0 = *(const f32x4*)(ba + ch), a1 = *(const f32x4*)(ba + ch + 4), b0 = *(const f32x4*)(bi + ch), b1 = *(const f32x4*)(bi + ch + 4), l0 = *(const f32x4*)(lam + ch), l1 = *(const f32x4*)(lam + ch + 4);
#pragma unroll
          for (int e = 0; e < 4; ++e) { vba[e] = a0[e]; vba[4 + e] = a1[e]; vbi[e] = b0[e]; vbi[4 + e] = b1[e]; vsp[e] = -8.0f * LOG2E * log1pf(__expf(-l0[e])); vsp[4 + e] = -8.0f * LOG2E * log1pf(__expf(-l1[e])); } }
        float h[8], pr[8];
#pragma unroll
        for (int e = 0; e < 8; ++e) { h[e] = 0.f; pr[e] = 1.f; }
        const bf16_t* gp = GP + (size_t)(sc * 16) * 4096 + gcol; const bf16_t* xc = XC + (size_t)(sc * 16) * D + ch;
        bf16_t* lb = LB + (size_t)(sc * 16) * D + ch; bf16_t* ub = UB + (size_t)(sc * 16) * D + ch;
#pragma unroll 1
        for (int r8 = 0; r8 < 16; r8 += 8) {
        u32x4 pav[8], piv[8], xvv[8];
#pragma unroll
        for (int i = 0; i < 8; ++i) { pav[i] = *(const u32x4*)(gp + (size_t)(r8 + i) * 4096); piv[i] = *(const u32x4*)(gp + (size_t)(r8 + i) * 4096 + 128); xvv[i] = *(const u32x4*)(xc + (size_t)(r8 + i) * D); }
#pragma unroll
        for (int i = 0; i < 8; ++i) {
            const int r = r8 + i;
            const u32x4 pa = pav[i], pi = piv[i], xv = xvv[i];
            float l[8];
#pragma unroll
            for (int e = 0; e < 8; ++e) l[e] = vsp[e] * sigmoidf_(bfe(pa, e) + vba[e]);
            const u32x4 lpk = {cvt_pk_bf16(l[0], l[1]), cvt_pk_bf16(l[2], l[3]), cvt_pk_bf16(l[4], l[5]), cvt_pk_bf16(l[6], l[7])};
            float a[8], u[8];
#pragma unroll
            for (int e = 0; e < 8; ++e) { a[e] = __builtin_amdgcn_exp2f(bfe(lpk, e)); u[e] = sqrtf(fmaxf(1.0f - a[e] * a[e], 0.f)) * sigmoidf_(bfe(pi, e) + vbi[e]) * bfe(xv, e); }
            const u32x4 upk = {cvt_pk_bf16(u[0], u[1]), cvt_pk_bf16(u[2], u[3]), cvt_pk_bf16(u[4], u[5]), cvt_pk_bf16(u[6], u[7])};
            *(u32x4*)(lb + (size_t)r * D) = lpk; *(u32x4*)(ub + (size_t)r * D) = upk;
#pragma unroll
            for (int e = 0; e < 8; ++e) { h[e] = a[e] * h[e] + bfe(upk, e); pr[e] *= a[e]; }
        }
        }
        float* eo = E + (size_t)sc * D + ch; float* po = AP + (size_t)sc * D + ch;
        *(f32x4*)(eo) = (f32x4){h[0], h[1], h[2], h[3]}; *(f32x4*)(eo + 4) = (f32x4){h[4], h[5], h[6], h[7]};
        *(f32x4*)(po) = (f32x4){pr[0], pr[1], pr[2], pr[3]}; *(f32x4*)(po + 4) = (f32x4){pr[4], pr[5], pr[6], pr[7]};
    }
}
__device__ __forceinline__ void scanc_phase(const float* __restrict__ E, const float* __restrict__ AP, float* __restrict__ CIN, LAS unsigned char* lds, int blk, int G) {
    int tid = threadIdx.x; asm volatile("" : "+v"(tid));
    LAS float* sP = (LAS float*)lds; LAS float* sE = sP + 512;
    const int k = tid & 7, g = tid >> 3;
    for (int unit = blk; unit < 256; unit += G) {
        const int ch = unit * 8 + k;
        float e[8], p[8];
#pragma unroll
        for (int i = 0; i < 8; ++i) { e[i] = E[(size_t)(g * 8 + i) * D + ch]; p[i] = AP[(size_t)(g * 8 + i) * D + ch]; }
        float Pg = 1.f, Eg = 0.f;
#pragma unroll
        for (int i = 0; i < 8; ++i) { Eg = p[i] * Eg + e[i]; Pg *= p[i]; }
        sP[tid] = Pg; sE[tid] = Eg;
        __syncthreads();
        if (tid < 8) { float hc = 0.f;
            for (int gg = 0; gg < 64; ++gg) { const float Pq = sP[gg * 8 + tid], Eq = sE[gg * 8 + tid]; sE[gg * 8 + tid] = hc; hc = Pq * hc + Eq; } }
        __syncthreads();
        float hc = sE[tid];
#pragma unroll
        for (int i = 0; i < 8; ++i) { CIN[(size_t)(g * 8 + i) * D + ch] = hc; hc = p[i] * hc + e[i]; }
        __syncthreads();
    }
}
__device__ __forceinline__ void scan2_phase(const bf16_t* __restrict__ LB, const bf16_t* __restrict__ UB, const float* __restrict__ CIN, const bf16_t* __restrict__ REC, bf16_t* __restrict__ HG, int blk, int G) {
    int tid = threadIdx.x; asm volatile("" : "+v"(tid));
    for (int unit = blk; unit < 256; unit += G) {
        const int sc = unit * 2 + (tid >> 8), ch = (tid & 255) * 8;
        float h[8];
        { const f32x4 c0 = *(const f32x4*)(CIN + (size_t)sc * D + ch), c1 = *(const f32x4*)(CIN + (size_t)sc * D + ch + 4);
#pragma unroll
          for (int e = 0; e < 4; ++e) { h[e] = c0[e]; h[4 + e] = c1[e]; } }
        const bf16_t* lb = LB + (size_t)(sc * 16) * D + ch; const bf16_t* ub = UB + (size_t)(sc * 16) * D + ch;
        const bf16_t* yb = REC + (size_t)(sc * 16) * 2 * D + D + ch; bf16_t* hg = HG + (size_t)(sc * 16) * D + ch;
#pragma unroll 1
        for (int r8 = 0; r8 < 16; r8 += 8) {
        u32x4 lv[8], uv8[8], yv[8];
#pragma unroll
        for (int i = 0; i < 8; ++i) { lv[i] = *(const u32x4*)(lb + (size_t)(r8 + i) * D); uv8[i] = *(const u32x4*)(ub + (size_t)(r8 + i) * D); yv[i] = *(const u32x4*)(yb + (size_t)(r8 + i) * 2 * D); }
#pragma unroll
        for (int i = 0; i < 8; ++i) {
            const int r = r8 + i;
            const u32x4 lpk = lv[i], upk = uv8[i], y = yv[i];
            float o[8];
#pragma unroll
            for (int e = 0; e < 8; ++e) h[e] = __builtin_amdgcn_exp2f(bfe(lpk, e)) * h[e] + bfe(upk, e);
#pragma unroll
            for (int e = 0; e < 4; ++e) { const f32x2 gy = gelu_tanh2((f32x2){bflo(y[e]), bfhi(y[e])}); o[2 * e] = h[2 * e] * gy.x; o[2 * e + 1] = h[2 * e + 1] * gy.y; }
            *(u32x4*)(hg + (size_t)r * D) = (u32x4){cvt_pk_bf16(o[0], o[1]), cvt_pk_bf16(o[2], o[3]), cvt_pk_bf16(o[4], o[5]), cvt_pk_bf16(o[6], o[7])};
        }
        }
    }
}

__device__ __forceinline__ int crow(int r, int hi) { return (r & 3) + 8 * (r >> 2) + 4 * hi; }
__device__ __forceinline__ void attn_phase(LAS unsigned char* lds, const bf16_t* __restrict__ QKV, bf16_t* __restrict__ AO, const float* __restrict__ qg, const float* __restrict__ kg, const float* __restrict__ sinks, int vcu, int G) {
    int tid = threadIdx.x; asm volatile("" : "+v"(tid));
    const int lane = tid & 63, wid = __builtin_amdgcn_readfirstlane(tid >> 6), r32 = lane & 31, hi = lane >> 5;
    constexpr int KS_STRIDE = 144, VT_STRIDE = 528, VT_OFF = 256 * KS_STRIDE;
    LAS unsigned char* Ks = lds; LAS unsigned char* VT = lds + VT_OFF;
    for (int unit = vcu; unit < 512; unit += G) {
        const int qb = unit >> 3, kvh = unit & 7;
#pragma unroll
        for (int i = 0; i < 4; ++i) {
            const int id = tid + 512 * i, w = id >> 3, c = id & 7; int grow = 128 * (qb - 1) + w; if (grow < 0) grow = 0;
            const bf16_t* rowp = QKV + (size_t)grow * QKVD;
            const u32x4 kr = *(const u32x4*)(rowp + D + kvh * 64 + c * 8), vr = *(const u32x4*)(rowp + D + 512 + kvh * 64 + c * 8);
            float kf[8] = {bflo(kr.x), bfhi(kr.x), bflo(kr.y), bfhi(kr.y), bflo(kr.z), bfhi(kr.z), bflo(kr.w), bfhi(kr.w)};
            float ss = 0.f;
#pragma unroll
            for (int e = 0; e < 8; ++e) ss += kf[e] * kf[e];
            ss += __shfl_xor(ss, 1); ss += __shfl_xor(ss, 2); ss += __shfl_xor(ss, 4);
            const float rs = rsqrtf(ss * (1.0f / 64.0f) + EPS);
            const f32x4 g0 = *(const f32x4*)(kg + c * 8), g1 = *(const f32x4*)(kg + c * 8 + 4);
            u32x4 ko; ko.x = cvt_pk_bf16(kf[0] * rs * g0[0], kf[1] * rs * g0[1]); ko.y = cvt_pk_bf16(kf[2] * rs * g0[2], kf[3] * rs * g0[3]);
            ko.z = cvt_pk_bf16(kf[4] * rs * g1[0], kf[5] * rs * g1[1]); ko.w = cvt_pk_bf16(kf[6] * rs * g1[2], kf[7] * rs * g1[3]);
            *(LAS u32x4*)(Ks + w * KS_STRIDE + c * 16) = ko;
            const int pos = (w & ~15) + 8 * ((w >> 2) & 1) + (w & 3) + 4 * ((w >> 3) & 1);
            LAS bf16_t* vt = (LAS bf16_t*)(VT + (c * 8) * VT_STRIDE + pos * 2);
            vt[0 * (VT_STRIDE / 2)] = (bf16_t)(vr.x & 0xffff); vt[1 * (VT_STRIDE / 2)] = (bf16_t)(vr.x >> 16);
            vt[2 * (VT_STRIDE / 2)] = (bf16_t)(vr.y & 0xffff); vt[3 * (VT_STRIDE / 2)] = (bf16_t)(vr.y >> 16);
            vt[4 * (VT_STRIDE / 2)] = (bf16_t)(vr.z & 0xffff); vt[5 * (VT_STRIDE / 2)] = (bf16_t)(vr.z >> 16);
            vt[6 * (VT_STRIDE / 2)] = (bf16_t)(vr.w & 0xffff); vt[7 * (VT_STRIDE / 2)] = (bf16_t)(vr.w >> 16);
        }
        __syncthreads();
        const int head = kvh * 4 + (wid >> 1);
        const float sink2 = sinks[head] * LOG2E;
#pragma unroll 1
        for (int st = 0; st < 2; ++st) {
            const int o32 = 64 * (wid & 1) + 32 * st;
            const size_t qrow = (size_t)(128 * qb + o32 + r32);
            bf16x8 qr[4];
            {
                float qf[4][8]; float ss = 0.f;
#pragma unroll
                for (int d0 = 0; d0 < 4; ++d0) { const u32x4 q = *(const u32x4*)(QKV + qrow * QKVD + head * 64 + d0 * 16 + hi * 8);
                    qf[d0][0] = bflo(q.x); qf[d0][1] = bfhi(q.x); qf[d0][2] = bflo(q.y); qf[d0][3] = bfhi(q.y); qf[d0][4] = bflo(q.z); qf[d0][5] = bfhi(q.z); qf[d0][6] = bflo(q.w); qf[d0][7] = bfhi(q.w);
#pragma unroll
                    for (int e = 0; e < 8; ++e) ss += qf[d0][e] * qf[d0][e]; }
                ss += __shfl_xor(ss, 32);
                const float rs = rsqrtf(ss * (1.0f / 64.0f) + EPS) * (0.125f * LOG2E);
#pragma unroll
                for (int d0 = 0; d0 < 4; ++d0) { const f32x4 g0 = *(const f32x4*)(qg + d0 * 16 + hi * 8), g1 = *(const f32x4*)(qg + d0 * 16 + hi * 8 + 4);
                    u32x4 w; w.x = cvt_pk_bf16(qf[d0][0] * rs * g0[0], qf[d0][1] * rs * g0[1]); w.y = cvt_pk_bf16(qf[d0][2] * rs * g0[2], qf[d0][3] * rs * g0[3]);
                    w.z = cvt_pk_bf16(qf[d0][4] * rs * g1[0], qf[d0][5] * rs * g1[1]); w.w = cvt_pk_bf16(qf[d0][6] * rs * g1[2], qf[d0][7] * rs * g1[3]);
                    qr[d0] = __builtin_bit_cast(bf16x8, w); }
            }
            f32x16 p[5];
#pragma unroll
            for (int t = 0; t < 5; ++t) {
                const int kbase = o32 + 32 * t;
                f32x16 accp = {};
#pragma unroll
                for (int d0 = 0; d0 < 4; ++d0) { const bf16x8 kf = *(const LAS bf16x8*)(Ks + (kbase + r32) * KS_STRIDE + d0 * 32 + hi * 16);
                    accp = __builtin_amdgcn_mfma_f32_32x32x16_bf16(kf, qr[d0], accp, 0, 0, 0); }
                p[t] = accp;
            }
            float mx = sink2;
#pragma unroll
            for (int t = 0; t < 5; ++t)
#pragma unroll
                for (int r = 0; r < 16; ++r) { const int w = o32 + 32 * t + crow(r, hi), rel = 128 + o32 + r32 - w;
                    const bool valid = (rel >= 0) && (rel < 128) && (qb > 0 || w >= 128);
                    const float v = valid ? p[t][r] : -INFINITY; p[t][r] = v; mx = fmaxf(mx, v); }
            mx = fmaxf(mx, __shfl_xor(mx, 32));
            float l = 0.f;
#pragma unroll
            for (int t = 0; t < 5; ++t)
#pragma unroll
                for (int r = 0; r < 16; ++r) { const float e = __builtin_amdgcn_exp2f(p[t][r] - mx); p[t][r] = e; l += e; }
            l += __shfl_xor(l, 32);
            l += __builtin_amdgcn_exp2f(sink2 - mx);
            const float inv = 1.0f / l;
            f32x16 o0 = {}, o1 = {};
#pragma unroll
            for (int t = 0; t < 5; ++t)
#pragma unroll
                for (int s = 0; s < 2; ++s) {
                    u32x4 pw; pw.x = cvt_pk_bf16(p[t][8 * s + 0], p[t][8 * s + 1]); pw.y = cvt_pk_bf16(p[t][8 * s + 2], p[t][8 * s + 3]); pw.z = cvt_pk_bf16(p[t][8 * s + 4], p[t][8 * s + 5]); pw.w = cvt_pk_bf16(p[t][8 * s + 6], p[t][8 * s + 7]);
                    const bf16x8 pb = __builtin_bit_cast(bf16x8, pw);
                    const int g16 = (o32 + 32 * t) / 16 + s;
                    const bf16x8 vf0 = *(const LAS bf16x8*)(VT + (r32) * VT_STRIDE + g16 * 32 + hi * 16);
                    const bf16x8 vf1 = *(const LAS bf16x8*)(VT + (32 + r32) * VT_STRIDE + g16 * 32 + hi * 16);
                    o0 = __builtin_amdgcn_mfma_f32_32x32x16_bf16(vf0, pb, o0, 0, 0, 0);
                    o1 = __builtin_amdgcn_mfma_f32_32x32x16_bf16(vf1, pb, o1, 0, 0, 0);
                }
            bf16_t* orow = AO + qrow * D + head * 64;
#pragma unroll
            for (int rg = 0; rg < 4; ++rg) {
                u32x2 w0, w1;
                w0.x = cvt_pk_bf16(o0[4 * rg + 0] * inv, o0[4 * rg + 1] * inv); w0.y = cvt_pk_bf16(o0[4 * rg + 2] * inv, o0[4 * rg + 3] * inv);
                w1.x = cvt_pk_bf16(o1[4 * rg + 0] * inv, o1[4 * rg + 1] * inv); w1.y = cvt_pk_bf16(o1[4 * rg + 2] * inv, o1[4 * rg + 3] * inv);
                *(u32x2*)(orow + 8 * rg + 4 * hi) = w0; *(u32x2*)(orow + 32 + 8 * rg + 4 * hi) = w1;
            }
        }
        __syncthreads();
    }
}


__device__ __forceinline__ void touch_phase(const u32x4* wp, int nchunk, unsigned* sink, int vcu, int G) {
    int tid = threadIdx.x; asm volatile("" : "+v"(tid));
    unsigned accx = 0u;
#pragma unroll 4
    for (int c = vcu * 512 + tid; c < nchunk; c += G * 512) { const u32x4 t = wp[c]; accx ^= t.x ^ t.y ^ t.z ^ t.w; }
    if (accx == 0x9e3779b9u && nchunk < 0) *sink = accx;
}

#define GAS __attribute__((address_space(1)))
#define XB_TMO      128
#define XB_XCNT(j)  (256  + 64 * (j))
#define XB_XSUB(j)  (1280 + 64 * (j))
#define XB_XGEN(j)  (2304 + 64 * (j))
#define XB_TOP      3328
#define XB_TOPGEN   3392
#define XCD_BAR_WORDS 3456
#define XB_SPIN_CAP (1u << 18)

__device__ __forceinline__ unsigned xb_ld(unsigned* p)              { return __hip_atomic_load(p, __ATOMIC_RELAXED, __HIP_MEMORY_SCOPE_AGENT); }
__device__ __forceinline__ unsigned xb_add(unsigned* p, unsigned v) { return __hip_atomic_fetch_add(p, v, __ATOMIC_RELAXED, __HIP_MEMORY_SCOPE_AGENT); }
__device__ __forceinline__ unsigned xb_xcc_id() { return (unsigned)__builtin_amdgcn_s_getreg((3 << 11) | 20) & 0xFu; }
#define XB_SPIN(cond, bar) do { unsigned _sp = 0; while (cond) { __builtin_amdgcn_s_sleep(1); \
    if ((++_sp & 255u) == 0u) { if (xb_ld(&(bar)[XB_TMO])) break; if (_sp > XB_SPIN_CAP) { atomicAdd(&(bar)[XB_TMO], 1u); break; } } } } while (0)

struct XcdBarrier {
    unsigned* bar; unsigned x;
    volatile LAS unsigned* st;
};

__device__ __forceinline__ XcdBarrier xcd_barrier_post(unsigned* bar, volatile LAS unsigned* st) {
    XcdBarrier b; b.bar = bar; b.x = xb_xcc_id(); b.st = st;
    if (threadIdx.x == 0) (void)xb_add(&bar[XB_XCNT(b.x)], 1u);
    return b;
}
__device__ __forceinline__ void xcd_barrier_complete(unsigned* bar, unsigned x, unsigned& nloc, unsigned& nx) {
    const unsigned G = gridDim.x * gridDim.y * gridDim.z;
    unsigned sum, cnt, mine, sp = 0u;
    for (;;) {
        sum = 0u; cnt = 0u; mine = 0u;
#pragma unroll
        for (unsigned j = 0; j < 16; ++j) { const unsigned c = xb_ld(&bar[XB_XCNT(j)]); sum += c; cnt += (c > 0u) ? 1u : 0u; mine = (j == x) ? c : mine; }
        if (sum == G) break;
        __builtin_amdgcn_s_sleep(1);
        if ((++sp & 255u) == 0u) { if (xb_ld(&bar[XB_TMO])) break; if (sp > XB_SPIN_CAP) { atomicAdd(&bar[XB_TMO], 1u); break; } }
    }
    nloc = mine > 0u ? mine : 1u; nx = cnt > 0u ? cnt : 1u;
}

__device__ __forceinline__ void xcd_barrier(const XcdBarrier& b) {
    asm volatile("s_waitcnt vmcnt(0)" ::: "memory");
    __syncthreads();
    if (threadIdx.x == 0) {
        unsigned* bar = b.bar;
        __builtin_amdgcn_s_waitcnt(0);
        unsigned nloc = b.st[0], nx = b.st[1];
        if (nloc == 0u) { xcd_barrier_complete(bar, b.x, nloc, nx); b.st[0] = nloc; b.st[1] = nx; }
        const unsigned old = xb_add(&bar[XB_XSUB(b.x)], 1u);
        const unsigned gen = old / nloc;
        if (old + 1u == (gen + 1u) * nloc) {
            __builtin_amdgcn_fence(__ATOMIC_RELEASE, "agent");
            asm volatile("s_waitcnt vmcnt(0)" ::: "memory");
            const unsigned og = xb_add(&bar[XB_TOP], 1u);
            const unsigned tg = og / nx;
            if (og + 1u == (tg + 1u) * nx) xb_add(&bar[XB_TOPGEN], 1u);
            else XB_SPIN(xb_ld(&bar[XB_TOPGEN]) == tg, bar);
            __builtin_amdgcn_fence(__ATOMIC_ACQUIRE, "agent");
            xb_add(&bar[XB_XGEN(b.x)], 1u);
            asm volatile("s_waitcnt vmcnt(0)" ::: "memory");
        } else {
            XB_SPIN(xb_ld(&bar[XB_XGEN(b.x)]) == gen, bar);
            __builtin_amdgcn_fence(__ATOMIC_ACQUIRE, "agent");
            asm volatile("s_waitcnt vmcnt(0)" ::: "memory");
        }
    }
    __syncthreads();
}
__global__ void __launch_bounds__(512, 2) fwd_megakernel(Args a) {
    extern __shared__ __attribute__((aligned(16))) unsigned char lds_raw[];
    LAS unsigned char* lds = (LAS unsigned char*)lds_raw;
    cg::grid_group grid = cg::this_grid();
    const int G = gridDim.x, bx = blockIdx.x;
    const int vcu = (G % 8 == 0) ? (bx % 8) * (G / 8) + bx / 8 : bx;

    volatile LAS unsigned* MISC = (volatile LAS unsigned*)(lds + MISC_OFF);
    if (threadIdx.x < 16) MISC[threadIdx.x] = 0u;
    unsigned* barw = (unsigned*)(a.ws + WS_BAR);
    if (bx == 0) for (int i = threadIdx.x; i < XCD_BAR_WORDS; i += 512) barw[i] = 0u;
    __syncthreads();
    prologue(a, lds, vcu, G);
    grid.sync();
    const XcdBarrier xbar = xcd_barrier_post(barw, MISC + 8);

#pragma unroll 1
    for (int step = 0; step < NSTEPS; ++step) {
        int layer, idx;
        if (step < 6) { layer = 0; idx = step; } else if (step < 16) { layer = 1; idx = step - 6; } else if (step < 22) { layer = 2; idx = step - 16; } else { layer = 3; idx = step - 22; }
        int kind = idx;
        if (layer & 1) kind = idx < 4 ? 6 + idx : (idx == 4 ? 12 : (idx < 7 ? 5 + idx : idx - 4));
        const int j = layer >> 1;
        unsigned char* ws = a.ws;
        unsigned long long* SSQ = (unsigned long long*)(ws + WS_SSQ);
        bf16_t* XB = (bf16_t*)(ws + WS_XB); bf16_t* QKV = (bf16_t*)(ws + WS_QKV); bf16_t* AO = (bf16_t*)(ws + WS_AO); bf16_t* REC = (bf16_t*)(ws + WS_REC); bf16_t* XC = (bf16_t*)(ws + WS_XC);
        bf16_t* GP = (bf16_t*)(ws + WS_GA); bf16_t* HG = (bf16_t*)(ws + WS_HG); bf16_t* P = (bf16_t*)(ws + WS_P); bf16_t* ACT = (bf16_t*)(ws + WS_ACT);
        float* CE = (float*)(ws + WS_CARRY); float* CAP = CE + 512 * D; float* CIN = CAP + 512 * D; bf16_t* LB = (bf16_t*)(ws + WS_GU); bf16_t* UB = LB + (size_t)T * D;
        if (kind == 3) {
            pg8::Gemm g; g.M = T; g.lda = D; g.ldb = D; g.K = D; g.agrp = 0; g.A = XB; g.Bt = (const bf16_t*)(ws + WS_WUP) + (size_t)layer * FF2 * D; g.N = FF2;
            pg8::EpiConvActP E; E.ACT = ACT; E.ssq = SSQ + (size_t)(2 * layer + 1) * T; E.cw = a.in[I_FCW] + (size_t)layer * 3 * FF2; E.cb = a.in[I_FCB] + (size_t)layer * FF2; E.halo = (float*)P; E.hl = lds + 131072;
            pg8::StaticOrder S; S.init(T, FF2, G, bx);
            pg8::gemm_phase<pg8::EpiConvActP, true, true>(lds, g, S, E);
        } else if (kind == 0 || kind == 6 || kind == 8) {
            pg8::Gemm g; pg8::EpiScaleBf16 E; g.M = T; g.lda = D; g.ldb = D; g.K = D; g.agrp = 0; g.A = XB;
            if (kind == 0)      { g.Bt = (const bf16_t*)(ws + WS_WQKV) + (size_t)j * QKVD * D; g.N = QKVD; E.O = QKV; E.ldc = QKVD; E.ssq = SSQ + (size_t)(2 * layer) * T; }
            else if (kind == 6) { g.Bt = (const bf16_t*)(ws + WS_WIN) + (size_t)j * 2 * D * D; g.N = 2 * D; E.O = REC; E.ldc = 2 * D; E.ssq = SSQ + (size_t)(2 * layer) * T; }
            else                { g.A = XC; g.Bt = (const bf16_t*)(ws + WS_WG) + (size_t)j * 4096 * 256; g.N = 4096; g.K = 256; g.ldb = 256; g.agrp = 512; E.O = GP; E.ldc = 4096; E.ssq = nullptr; }
            pg8::StaticOrder S; S.init(T, g.N, G, bx);
            pg8::gemm_phase<pg8::EpiScaleBf16, true>(lds, g, S, E);
            if (DEFER_CONV && kind == 0) {
                const int first_idle = 384 - G, jb0 = layer == 0 ? 8 : 28;
                if (first_idle > 0 && first_idle < G) { if (bx >= first_idle) convert_jobs(a, lds, jb0, jb0 + 20, bx - first_idle, G - first_idle); }
                else convert_jobs(a, lds, jb0, jb0 + 20, bx, G);
            }
        } else if (kind == 2 || kind == 5 || kind == 11) {
            pg8::Gemm g; pg8::EpiResid E; g.M = T; g.N = D; g.lda = D; g.ldb = D; g.K = D; g.agrp = 0;
            E.xold_f32 = nullptr; E.xnew_f32 = nullptr; E.xb = XB; E.ssq = SSQ + (size_t)(2 * layer + 1) * T;
            if (kind == 2)      { g.A = AO; g.Bt = (const bf16_t*)(ws + WS_WO) + (size_t)j * D * D; if (layer == 0) E.xold_f32 = a.in[I_X]; }
            else if (kind == 11){ g.A = HG; g.Bt = (const bf16_t*)(ws + WS_WOUT) + (size_t)j * D * D; }
            else                { g.A = ACT; g.Bt = (const bf16_t*)(ws + WS_WDN) + (size_t)layer * D * FF; g.K = FF; g.lda = FF; g.ldb = FF; E.ssq = layer < 3 ? SSQ + (size_t)(2 * layer + 2) * T : nullptr; if (layer == 3) E.xnew_f32 = a.out; }
            pg8::StaticOrder S; S.init(T, D, G, bx);
            pg8::gemm_phase<pg8::EpiResid, true>(lds, g, S, E);
        } else if (kind == 1) {
            attn_phase(lds, QKV, AO, a.in[I_QG] + j * 64, a.in[I_KG] + j * 64, a.in[I_SINK] + j * 32, vcu, G);
        } else if (kind == 4) {
            ffn_fix_phase((const float*)P, a.in[I_FCW] + (size_t)layer * 3 * FF2, a.in[I_FCB] + (size_t)layer * FF2, ACT, vcu, G);
            touch_phase((const u32x4*)((const bf16_t*)(ws + WS_WDN) + (size_t)layer * D * FF), D * FF * 2 / 16, (unsigned*)(ws + WS_BAR + 65536), vcu, G);
        } else if (kind == 7) {
            rec_conv_phase(REC, a.in[I_RCW] + (size_t)j * 4 * D, a.in[I_RCB] + (size_t)j * D, XC, vcu, G);
        } else if (kind == 9) {
            scan1_phase(GP, XC, a.in[I_BA] + (size_t)j * D, a.in[I_BI] + (size_t)j * D, a.in[I_LAM] + (size_t)j * D, LB, UB, CE, CAP, vcu, G);
        } else if (kind == 12) {
            scanc_phase(CE, CAP, CIN, lds, vcu, G);
        } else {
            scan2_phase(LB, UB, CIN, REC, HG, vcu, G);
        }
        if (step < NSTEPS - 1) xcd_barrier(xbar);
    }
}

extern "C" void kernel_launch(void* const* d_in, const int* in_sizes, int n_in, void* d_out, int out_size, void* d_ws, size_t ws_size, hipStream_t stream) {
    static int grid = 0;
    if (grid == 0) {
        if (n_in != 21 || out_size != T * D || ws_size < WS_END) { fprintf(stderr, "kernel_launch: unexpected problem (n_in %d out %d ws %zu)\n", n_in, out_size, ws_size); grid = -1; return; }
        int dev = 0, cus = 0, per_cu = 0;
        hipGetDevice(&dev); hipDeviceGetAttribute(&cus, hipDeviceAttributeMultiprocessorCount, dev);
        if (hipFuncSetAttribute((const void*)fwd_megakernel, hipFuncAttributeMaxDynamicSharedMemorySize, LDS_BYTES) != hipSuccess) { fprintf(stderr, "kernel_launch: hipFuncSetAttribute failed\n"); grid = -1; return; }
        if (hipOccupancyMaxActiveBlocksPerMultiprocessor(&per_cu, (const void*)fwd_megakernel, 512, LDS_BYTES) != hipSuccess || per_cu < 1) { fprintf(stderr, "kernel_launch: occupancy query says %d\n", per_cu); per_cu = 1; }
        (void)hipGetLastError();
        grid = cus * 1;
    }
    if (grid < 0) return;
    Args a{};
    for (int i = 0; i < 21; ++i) a.in[i] = (const float*)d_in[i];
    a.out = (float*)d_out; a.ws = (unsigned char*)d_ws;
    void* args[] = {&a};
    hipError_t e = hipLaunchCooperativeKernel((const void*)fwd_megakernel, dim3(grid), dim3(512), args, LDS_BYTES, stream);
    if (e != hipSuccess) fprintf(stderr, "cooperative launch failed: %s (grid %d)\n", hipGetErrorString(e), grid);
}
```

```cpp
#include <hip/hip_runtime.h>
#include <hip/hip_cooperative_groups.h>
#include <cstdio>
#include <cstdint>
namespace cg = cooperative_groups;

#define LAS __attribute__((address_space(3)))
typedef unsigned short bf16_t;
typedef short bf16x8 __attribute__((ext_vector_type(8)));
typedef float f32x4 __attribute__((ext_vector_type(4)));
typedef float f32x2 __attribute__((ext_vector_type(2)));
typedef float f32x16 __attribute__((ext_vector_type(16)));
typedef unsigned u32x4 __attribute__((ext_vector_type(4)));
typedef unsigned u32x2 __attribute__((ext_vector_type(2)));

constexpr int T = 8192, D = 2048, QKVD = 3072, FF = 6144, FF2 = 12288;
constexpr float EPS = 1e-6f;
constexpr float LOG2E = 1.4426950408889634f;
constexpr float SSQ_SCALE = 4294967296.0f, SSQ_INV = 1.0f / 4294967296.0f;

constexpr size_t MiB = 1u << 20;
constexpr size_t WS_SSQ = 0;
constexpr size_t WS_BAR = 1 * MiB;
constexpr size_t WS_CARRY = 2 * MiB;
constexpr size_t WS_WQKV = 16 * MiB, WS_WO = 40 * MiB, WS_WIN = 56 * MiB, WS_WG = 88 * MiB, WS_WOUT = 92 * MiB, WS_WUP = 108 * MiB, WS_WDN = 300 * MiB;
constexpr size_t WS_XB = 400 * MiB, WS_QKV = 432 * MiB, WS_AO = 480 * MiB, WS_REC = 512 * MiB, WS_XC = 576 * MiB, WS_GA = 608 * MiB, WS_GU = 672 * MiB,
                 WS_HG = 736 * MiB, WS_P = 768 * MiB, WS_ACT = 960 * MiB, WS_END = 1056 * MiB;

constexpr int LDS_BYTES = 147456, MISC_OFF = 147200, NSTEPS = 32;
#ifndef DEFER_CONV
#define DEFER_CONV 1
#endif

__device__ __forceinline__ unsigned cvt_pk_bf16(float lo, float hi) { unsigned r; asm volatile("v_cvt_pk_bf16_f32 %0, %1, %2" : "=v"(r) : "v"(lo), "v"(hi)); return r; }
__device__ __forceinline__ float bflo(unsigned w) { return __uint_as_float(w << 16); }
__device__ __forceinline__ float bfhi(unsigned w) { return __uint_as_float(w & 0xffff0000u); }
__device__ __forceinline__ float gelu_tanh(float x) {
    const float z = 0.7978845608028654f * (x + 0.044715f * x * x * x);
    return x * __builtin_amdgcn_rcpf(1.0f + __builtin_amdgcn_exp2f(-2.0f * LOG2E * z));
}
__device__ __forceinline__ f32x2 gelu_tanh2(f32x2 x) {
    const f32x2 w = (x * x) * 0.044715f + 1.0f;
    const f32x2 t = (x * w) * (-2.0f * LOG2E * 0.7978845608028654f);
    f32x2 e; e.x = __builtin_amdgcn_exp2f(t.x); e.y = __builtin_amdgcn_exp2f(t.y);
    const f32x2 d = e + 1.0f;
    f32x2 r; r.x = __builtin_amdgcn_rcpf(d.x); r.y = __builtin_amdgcn_rcpf(d.y);
    return x * r;
}
__device__ __forceinline__ float sigmoidf_(float v) { return __builtin_amdgcn_rcpf(1.0f + __builtin_amdgcn_exp2f(-LOG2E * v)); }

namespace pg8 {
constexpr int BM = 256, BK = 64, HALF = 128, HTB = HALF * BK * 2, STAGE_BYTES = 8 * HTB, NXCD = 8, WGM = 8;
__host__ __device__ __forceinline__ int lds_byte(int r, int c) { const int st = (r >> 4) * 2 + (c >> 5), rr = r & 15, cc = c & 31, ob = rr * 64 + cc * 2; return st * 1024 + (ob ^ (((ob >> 9) & 1) << 5)); }
__host__ __device__ __forceinline__ void stage_rc(int b, int& R, int& C) { const int st = b / 1024, sb = b % 1024, swz = sb ^ (((sb >> 9) & 1) << 5); R = (st >> 1) * 16 + swz / 64; C = (st & 1) * 32 + (swz % 64) / 2; }
__host__ __device__ __forceinline__ int perm32(int rho) { const int n = rho >> 4, i = rho & 15; return 8 * (i >> 2) + 4 * n + (i & 3); }

struct Unit { int pm, pn; };
struct Gemm { const bf16_t* A; const bf16_t* Bt; int M, N, K, lda, ldb, agrp; };

struct StaticOrder {
    int nM, nN, nwg, G, c;
    __host__ __device__ void init(int M, int N, int G_, int c_) { nM = M / BM; nN = N / BM; nwg = nM * nN; G = G_; c = c_; }
    __host__ __device__ bool next(int i, Unit& u) const {
        const long L = (long)i * G + c; if (L >= nwg) return false;
        int wgid = (int)L; { const int q = nwg / NXCD, r = nwg % NXCD, xcd = wgid % NXCD, off = wgid / NXCD; wgid = (xcd < r ? xcd * (q + 1) : r * (q + 1) + (xcd - r) * q) + off; }
        const int nig = WGM * nN, gid = wgid / nig, fm = gid * WGM, gsz = (nM - fm) < WGM ? (nM - fm) : WGM;
        u.pm = fm + ((wgid % nig) % gsz); u.pn = (wgid % nig) / gsz; return true;
    }
};


struct EpiScaleBf16 {
    bf16_t* O; int ldc; const unsigned long long* ssq;
    __device__ __forceinline__ void operator()(const f32x4 (&acc)[2][2][4][2], const Unit& u, int wr, int wc, int fr, int fq) const {
        const int row0 = u.pm * BM + wr * 64 + fr, col0 = u.pn * BM + wc * 32 + 8 * fq;
#pragma unroll
        for (int ai = 0; ai < 2; ++ai)
#pragma unroll
            for (int m = 0; m < 4; ++m) {
                const int row = row0 + ai * HALF + m * 16;
                const float rs = ssq ? rsqrtf((float)ssq[row] * SSQ_INV * (1.0f / D) + EPS) : 1.0f;
                bf16_t* rowp = O + (size_t)row * ldc + col0;
#pragma unroll
                for (int bj = 0; bj < 2; ++bj) { const f32x4 v0 = acc[ai][bj][m][0] * rs, v1 = acc[ai][bj][m][1] * rs;
                    u32x4 w; w.x = cvt_pk_bf16(v0[0], v0[1]); w.y = cvt_pk_bf16(v0[2], v0[3]); w.z = cvt_pk_bf16(v1[0], v1[1]); w.w = cvt_pk_bf16(v1[2], v1[3]);
                    *(u32x4*)(rowp + bj * HALF) = w; } }
    }
};
struct EpiResid {
    const float* xold_f32; float* xnew_f32; bf16_t* xb; unsigned long long* ssq;
    __device__ __forceinline__ void finish_row(const f32x4 (&o)[2][2], int row, size_t off, int fq) const {
        float s = 0.f;
#pragma unroll
        for (int bj = 0; bj < 2; ++bj) { const f32x4 o0 = o[bj][0], o1 = o[bj][1];
            if (xnew_f32) { *(f32x4*)(xnew_f32 + off + bj * HALF) = o0; *(f32x4*)(xnew_f32 + off + bj * HALF + 4) = o1; }
            else *(u32x4*)(xb + off + bj * HALF) = (u32x4){cvt_pk_bf16(o0[0], o0[1]), cvt_pk_bf16(o0[2], o0[3]), cvt_pk_bf16(o1[0], o1[1]), cvt_pk_bf16(o1[2], o1[3])};
            const f32x4 q = o0 * o0 + o1 * o1; s += (q[0] + q[1]) + (q[2] + q[3]); }
        if (ssq) { s += __shfl_xor(s, 16); s += __shfl_xor(s, 32);
            if (fq == 0) __hip_atomic_fetch_add(ssq + row, (unsigned long long)(s * SSQ_SCALE), __ATOMIC_RELAXED, __HIP_MEMORY_SCOPE_AGENT); }
    }
    __device__ __forceinline__ void operator()(const f32x4 (&acc)[2][2][4][2], const Unit& u, int wr, int wc, int fr, int fq) const {
        const int row0 = u.pm * BM + wr * 64 + fr, col0 = u.pn * BM + wc * 32 + 8 * fq;
        if (xold_f32) {
#pragma unroll
            for (int ai = 0; ai < 2; ++ai)
#pragma unroll
                for (int m = 0; m < 4; ++m) {
                    const int row = row0 + ai * HALF + m * 16; const size_t off = (size_t)row * D + col0;
                    f32x4 o[2][2];
#pragma unroll
                    for (int bj = 0; bj < 2; ++bj) { o[bj][0] = *(const f32x4*)(xold_f32 + off + bj * HALF) + acc[ai][bj][m][0]; o[bj][1] = *(const f32x4*)(xold_f32 + off + bj * HALF + 4) + acc[ai][bj][m][1]; }
                    finish_row(o, row, off, fq);
                }
            return;
        }
        u32x4 xr[2][4][2];
#pragma unroll
        for (int ai = 0; ai < 2; ++ai)
#pragma unroll
            for (int m = 0; m < 4; ++m)
#pragma unroll
                for (int bj = 0; bj < 2; ++bj) xr[ai][m][bj] = *(const u32x4*)(xb + (size_t)(row0 + ai * HALF + m * 16) * D + col0 + bj * HALF);
#pragma unroll
        for (int ai = 0; ai < 2; ++ai)
#pragma unroll
            for (int m = 0; m < 4; ++m) {
                const int row = row0 + ai * HALF + m * 16; const size_t off = (size_t)row * D + col0;
                f32x4 o[2][2];
#pragma unroll
                for (int bj = 0; bj < 2; ++bj) { const u32x4 x = xr[ai][m][bj];
                    o[bj][0] = (f32x4){bflo(x.x), bfhi(x.x), bflo(x.y), bfhi(x.y)} + acc[ai][bj][m][0]; o[bj][1] = (f32x4){bflo(x.z), bfhi(x.z), bflo(x.w), bfhi(x.w)} + acc[ai][bj][m][1]; }
                finish_row(o, row, off, fq);
            }
    }
};
template <int CTRL> __device__ __forceinline__ float dppf(float old, float src) {
    return __int_as_float(__builtin_amdgcn_update_dpp(__float_as_int(old), __float_as_int(src), CTRL, 0xf, 0xf, false));
}
template <int CTRL> __device__ __forceinline__ float dpp0(float src) {
    return __int_as_float(__builtin_amdgcn_update_dpp(0, __float_as_int(src), CTRL, 0xf, 0xf, true));
}
template <int S> __device__ __forceinline__ float rowprev(float cur, float pb) {
    const float o = dppf<0x100 + 16 - S>(0.f, pb);
    return dppf<0x110 + S>(o, cur);
}
struct EpiConvAct {
    bf16_t* ACT; const unsigned long long* ssq; const float* cw; const float* cb; float* halo; LAS unsigned char* hl;
    __device__ __forceinline__ void operator()(f32x4 (&acc)[2][2][4][2], const Unit& u, int wr, int wc, int fr, int fq) const {
        const int row0 = u.pm * BM + wr * 64 + fr, tcol = wc * 32 + 8 * fq;
#pragma unroll
        for (int ai = 0; ai < 2; ++ai)
#pragma unroll
            for (int m = 0; m < 4; ++m) {
                const float rs = rsqrtf((float)ssq[row0 + ai * HALF + m * 16] * SSQ_INV * (1.0f / D) + EPS);
#pragma unroll
                for (int bj = 0; bj < 2; ++bj)
#pragma unroll
                    for (int n = 0; n < 2; ++n) acc[ai][bj][m][n] = acc[ai][bj][m][n] * rs; }
        if (fr >= 14) {
#pragma unroll
            for (int ai = 0; ai < 2; ++ai)
#pragma unroll
                for (int bj = 0; bj < 2; ++bj)
#pragma unroll
                    for (int n = 0; n < 2; ++n) *(LAS f32x4*)(hl + ((((2 * ai + wr) * 2 + (fr - 14)) * 256) + bj * HALF + tcol + 4 * n) * 4) = acc[ai][bj][3][n];
            if (wr == 1) {
#pragma unroll
                for (int bj = 0; bj < 2; ++bj)
#pragma unroll
                    for (int n = 0; n < 2; ++n) *(f32x4*)(halo + (size_t)(u.pm * 4 + 2 + fr - 14) * FF2 + u.pn * BM + bj * HALF + tcol + 4 * n) = acc[1][bj][3][n]; }
        }
        if (wr == 0 && fr < 2) {
#pragma unroll
            for (int bj = 0; bj < 2; ++bj)
#pragma unroll
                for (int n = 0; n < 2; ++n) *(f32x4*)(halo + (size_t)(u.pm * 4 + fr) * FF2 + u.pn * BM + bj * HALF + tcol + 4 * n) = acc[0][bj][0][n]; }
        asm volatile("s_waitcnt lgkmcnt(0)" ::: "memory"); __builtin_amdgcn_s_barrier(); asm volatile("" ::: "memory");
        const int ch0 = u.pn * HALF + tcol;
        u32x2 pk[2][4][2];
#pragma unroll
        for (int n = 0; n < 2; ++n) {
            const float* cwp = cw + ch0 + 4 * n;
            const f32x4 wg0 = *(const f32x4*)(cwp), wg1 = *(const f32x4*)(cwp + FF2), wg2 = *(const f32x4*)(cwp + 2 * FF2), bg = *(const f32x4*)(cb + ch0 + 4 * n);
            const f32x4 wv0 = *(const f32x4*)(cwp + FF), wv1 = *(const f32x4*)(cwp + FF2 + FF), wv2 = *(const f32x4*)(cwp + 2 * FF2 + FF), bv = *(const f32x4*)(cb + FF + ch0 + 4 * n);
#pragma unroll
            for (int ai = 0; ai < 2; ++ai) {
                const int q = 2 * ai + wr;
                f32x4 pg = {0.f, 0.f, 0.f, 0.f}, pv = {0.f, 0.f, 0.f, 0.f};
                if (q > 0 && fr >= 14) { pg = *(const LAS f32x4*)(hl + ((((q - 1) * 2 + (fr - 14)) * 256) + tcol + 4 * n) * 4); pv = *(const LAS f32x4*)(hl + ((((q - 1) * 2 + (fr - 14)) * 256) + HALF + tcol + 4 * n) * 4); }
#pragma unroll
                for (int m = 0; m < 4; ++m) {
                    const f32x4 cg = acc[ai][0][m][n], cv = acc[ai][1][m][n];
                    const f32x4 gp = m > 0 ? acc[ai][0][m > 0 ? m - 1 : 0][n] : pg, vp = m > 0 ? acc[ai][1][m > 0 ? m - 1 : 0][n] : pv;
                    float ugv[4], uvv[4];
                    const f32x4 ug4 = wg2 * cg + bg, uv4 = wv2 * cv + bv;
#pragma unroll
                    for (int e = 0; e < 4; ++e) {
                        float ug = ug4[e], uv = uv4[e];
                        asm("v_fmac_f32_dpp %0, %1, %2 row_shr:1 row_mask:0xf bank_mask:0xf\n\tv_fmac_f32_dpp %0, %3, %2 row_shl:15 row_mask:0xf bank_mask:0xf" : "+v"(ug) : "v"(cg[e]), "v"(wg1[e]), "v"(gp[e]));
                        asm("v_fmac_f32_dpp %0, %1, %2 row_shr:2 row_mask:0xf bank_mask:0xf\n\tv_fmac_f32_dpp %0, %3, %2 row_shl:14 row_mask:0xf bank_mask:0xf" : "+v"(ug) : "v"(cg[e]), "v"(wg0[e]), "v"(gp[e]));
                        asm("v_fmac_f32_dpp %0, %1, %2 row_shr:1 row_mask:0xf bank_mask:0xf\n\tv_fmac_f32_dpp %0, %3, %2 row_shl:15 row_mask:0xf bank_mask:0xf" : "+v"(uv) : "v"(cv[e]), "v"(wv1[e]), "v"(vp[e]));
                        asm("v_fmac_f32_dpp %0, %1, %2 row_shr:2 row_mask:0xf bank_mask:0xf\n\tv_fmac_f32_dpp %0, %3, %2 row_shl:14 row_mask:0xf bank_mask:0xf" : "+v"(uv) : "v"(cv[e]), "v"(wv0[e]), "v"(vp[e]));
                        ugv[e] = ug; uvv[e] = uv; }
                    const f32x2 o01 = gelu_tanh2((f32x2){ugv[0], ugv[1]}) * (f32x2){uvv[0], uvv[1]}, o23 = gelu_tanh2((f32x2){ugv[2], ugv[3]}) * (f32x2){uvv[2], uvv[3]};

                    pk[ai][m][n] = (u32x2){cvt_pk_bf16(o01.x, o01.y), cvt_pk_bf16(o23.x, o23.y)};
                }
            }
        }
#pragma unroll
        for (int ai = 0; ai < 2; ++ai)
#pragma unroll
            for (int m = 0; m < 4; ++m)
                *(u32x4*)(ACT + (size_t)(row0 + ai * HALF + m * 16) * FF + ch0) = (u32x4){pk[ai][m][0].x, pk[ai][m][0].y, pk[ai][m][1].x, pk[ai][m][1].y};
    }
};
__device__ __forceinline__ float dpp_shr1_keep(float old, float src) { return __int_as_float(__builtin_amdgcn_update_dpp(__float_as_int(old), __float_as_int(src), 0x111, 0xf, 0xf, false)); }
__device__ __forceinline__ void conv3_rows(const f32x4& x0, const f32x4& x1, const f32x4& x2, const f32x4& x3, const f32x4& p2, const f32x4& p3,
                                           const f32x4& w0, const f32x4& w1, const f32x4& w2, const f32x4& b, f32x4 (&u)[4]) {
    f32x4 t3, t2;
#pragma unroll
    for (int e = 0; e < 4; ++e) { t3[e] = dpp_shr1_keep(p3[e], x3[e]); t2[e] = dpp_shr1_keep(p2[e], x2[e]); }
    u[0] = w2 * x0 + b; u[0] = w1 * t3 + u[0]; u[0] = w0 * t2 + u[0];
    u[1] = w2 * x1 + b; u[1] = w1 * x0 + u[1]; u[1] = w0 * t3 + u[1];
    u[2] = w2 * x2 + b; u[2] = w1 * x1 + u[2]; u[2] = w0 * x0 + u[2];
    u[3] = w2 * x3 + b; u[3] = w1 * x2 + u[3]; u[3] = w0 * x1 + u[3];
}
struct EpiConvActP {
    bf16_t* ACT; const unsigned long long* ssq; const float* cw; const float* cb; float* halo; LAS unsigned char* hl;
    __device__ __forceinline__ void operator()(f32x4 (&acc)[2][2][4][2], const Unit& u, int wr, int wc, int fr, int fq) const {
        const int rowb = u.pm * BM + wr * 64 + 4 * fr, tcol = wc * 32 + 8 * fq;
#pragma unroll
        for (int ai = 0; ai < 2; ++ai)
#pragma unroll
            for (int m = 0; m < 4; ++m) {
                const float rs = rsqrtf((float)ssq[rowb + ai * HALF + m] * SSQ_INV * (1.0f / D) + EPS);
#pragma unroll
                for (int bj = 0; bj < 2; ++bj)
#pragma unroll
                    for (int n = 0; n < 2; ++n) acc[ai][bj][m][n] = acc[ai][bj][m][n] * rs; }
        if (fr == 15) {
#pragma unroll
            for (int ai = 0; ai < 2; ++ai)
#pragma unroll
                for (int bj = 0; bj < 2; ++bj)
#pragma unroll
                    for (int n = 0; n < 2; ++n) { LAS unsigned char* hp = hl + ((((2 * ai + wr) * 2) * 256) + bj * HALF + tcol + 4 * n) * 4;
                        *(LAS f32x4*)(hp) = acc[ai][bj][2][n]; *(LAS f32x4*)(hp + 1024) = acc[ai][bj][3][n]; }
            if (wr == 1) {
#pragma unroll
                for (int bj = 0; bj < 2; ++bj)
#pragma unroll
                    for (int n = 0; n < 2; ++n) { float* gp = halo + (size_t)(u.pm * 4 + 2) * FF2 + u.pn * BM + bj * HALF + tcol + 4 * n;
                        *(f32x4*)(gp) = acc[1][bj][2][n]; *(f32x4*)(gp + FF2) = acc[1][bj][3][n]; } }
        }
        if (wr == 0 && fr == 0) {
#pragma unroll
            for (int bj = 0; bj < 2; ++bj)
#pragma unroll
                for (int n = 0; n < 2; ++n) { float* gp = halo + (size_t)(u.pm * 4) * FF2 + u.pn * BM + bj * HALF + tcol + 4 * n;
                    *(f32x4*)(gp) = acc[0][bj][0][n]; *(f32x4*)(gp + FF2) = acc[0][bj][1][n]; } }
        asm volatile("s_waitcnt lgkmcnt(0)" ::: "memory"); __builtin_amdgcn_s_barrier(); asm volatile("" ::: "memory");
        const int ch0 = u.pn * HALF + tcol;
        u32x2 pk[2][4][2];
#pragma unroll
        for (int n = 0; n < 2; ++n) {
            const float* cwp = cw + ch0 + 4 * n;
            const f32x4 wg0 = *(const f32x4*)(cwp), wg1 = *(const f32x4*)(cwp + FF2), wg2 = *(const f32x4*)(cwp + 2 * FF2), bg = *(const f32x4*)(cb + ch0 + 4 * n);
            const f32x4 wv0 = *(const f32x4*)(cwp + FF), wv1 = *(const f32x4*)(cwp + FF2 + FF), wv2 = *(const f32x4*)(cwp + 2 * FF2 + FF), bv = *(const f32x4*)(cb + FF + ch0 + 4 * n);
#pragma unroll
            for (int ai = 0; ai < 2; ++ai) {
                const int q = 2 * ai + wr;
                f32x4 pg2 = {0.f, 0.f, 0.f, 0.f}, pg3 = pg2, pv2 = pg2, pv3 = pg2;
                if (q > 0 && fr == 0) { const LAS unsigned char* hp = hl + ((((q - 1) * 2) * 256) + tcol + 4 * n) * 4;
                    pg2 = *(const LAS f32x4*)(hp); pg3 = *(const LAS f32x4*)(hp + 1024); pv2 = *(const LAS f32x4*)(hp + HALF * 4); pv3 = *(const LAS f32x4*)(hp + 1024 + HALF * 4); }
                f32x4 ug[4], uv[4];
                conv3_rows(acc[ai][0][0][n], acc[ai][0][1][n], acc[ai][0][2][n], acc[ai][0][3][n], pg2, pg3, wg0, wg1, wg2, bg, ug);
                conv3_rows(acc[ai][1][0][n], acc[ai][1][1][n], acc[ai][1][2][n], acc[ai][1][3][n], pv2, pv3, wv0, wv1, wv2, bv, uv);
#pragma unroll
                for (int m = 0; m < 4; ++m) {
                    const f32x2 o01 = gelu_tanh2((f32x2){ug[m][0], ug[m][1]}) * (f32x2){uv[m][0], uv[m][1]}, o23 = gelu_tanh2((f32x2){ug[m][2], ug[m][3]}) * (f32x2){uv[m][2], uv[m][3]};
                    pk[ai][m][n] = (u32x2){cvt_pk_bf16(o01.x, o01.y), cvt_pk_bf16(o23.x, o23.y)};
                }
            }
        }
#pragma unroll
        for (int ai = 0; ai < 2; ++ai)
#pragma unroll
            for (int m = 0; m < 4; ++m)
                *(u32x4*)(ACT + (size_t)(rowb + ai * HALF + m) * FF + ch0) = (u32x4){pk[ai][m][0].x, pk[ai][m][0].y, pk[ai][m][1].x, pk[ai][m][1].y};
    }
};
template <class Epi, bool ALIGN_EPI, bool APERM = false>
__device__ __forceinline__ void gemm_phase(LAS unsigned char* lds, const Gemm g, const StaticOrder& S, const Epi& E) {
    int tid = threadIdx.x; asm volatile("" : "+v"(tid));
    const int wid = __builtin_amdgcn_readfirstlane(tid >> 6), lane = tid & 63, wr = wid >> 2, wc = wid & 3, fr = lane & 15, fq = lane >> 4;
    const int nt = g.K / BK;
    unsigned voffA[2], voffB[2];
#pragma unroll
    for (int i = 0; i < 2; ++i) { int R, C; stage_rc(tid * 16 + i * 8192, R, C); const int Rb = (R & ~31) + perm32(R & 31);
        const int Ra = APERM ? ((R & 64) + 4 * (R & 15) + ((R >> 4) & 3)) : R;
        voffA[i] = (unsigned)(Ra * g.lda + C) * 2u; voffB[i] = (unsigned)(Rb * g.ldb + C) * 2u; }
    const size_t kstep = (size_t)(BK * 2);
    const size_t hstepA = (size_t)HALF * g.lda * 2, hstepB = (size_t)HALF * g.ldb * 2;
    const size_t tstepA = 2 * hstepA, tstepB = 2 * hstepB;
    const unsigned ldsw = (unsigned)wid * 1024u;
    const int aoff = lds_byte(wr * 64 + fr, fq * 8), boff = lds_byte(wc * 32 + fr, fq * 8);
#define PG8_SA(b, h) (((b) * 2 + (h)) * HTB)
#define PG8_SB(b, h) ((4 + (b) * 2 + (h)) * HTB)
#define PG8_STAGE(bufoff, gbase, voff) do { _Pragma("unroll") for (int _i = 0; _i < 2; ++_i) \
        __builtin_amdgcn_global_load_lds((const unsigned*)((const char*)(gbase) + (voff)[_i]), (LAS unsigned*)(lds + (bufoff) + ldsw + _i * 8192), 16, 0, 0); } while (0)
#define PG8_LDA(dst, b, h) do { _Pragma("unroll") for (int m = 0; m < 4; ++m) _Pragma("unroll") for (int k = 0; k < 2; ++k) dst[m][k] = *(const LAS bf16x8*)(lds + PG8_SA(b, h) + aoff + m * 2048 + k * 1024); } while (0)
#define PG8_LDB(dst, b, h) do { _Pragma("unroll") for (int n = 0; n < 2; ++n) _Pragma("unroll") for (int k = 0; k < 2; ++k) dst[n][k] = *(const LAS bf16x8*)(lds + PG8_SB(b, h) + boff + n * 2048 + k * 1024); } while (0)
#define PG8_MMA(ai, bj, At, Bt) do { __builtin_amdgcn_s_setprio(1); _Pragma("unroll") for (int m = 0; m < 4; ++m) _Pragma("unroll") for (int n = 0; n < 2; ++n) _Pragma("unroll") for (int k = 0; k < 2; ++k) \
        acc[ai][bj][m][n] = __builtin_amdgcn_mfma_f32_16x16x32_bf16(Bt[n][k], At[m][k], acc[ai][bj][m][n], 0, 0, 0); __builtin_amdgcn_s_setprio(0); } while (0)
#define PG8_WAIT_V(n) asm volatile("s_waitcnt vmcnt(" #n ")" ::: "memory")
#define PG8_WAIT_L(n) asm volatile("s_waitcnt lgkmcnt(" #n ")" ::: "memory")
#define PG8_BAR __builtin_amdgcn_s_barrier()
#define PG8_SCHED __builtin_amdgcn_sched_barrier(0)
    Unit cur, nxt; int ui = 0;
    if (!S.next(0, cur)) return;
    f32x4 acc[2][2][4][2];
#pragma unroll
    for (int a = 0; a < 2; ++a)
#pragma unroll
        for (int b = 0; b < 2; ++b)
#pragma unroll
            for (int m = 0; m < 4; ++m)
#pragma unroll
                for (int n = 0; n < 2; ++n) acc[a][b][m][n] = (f32x4){0.f, 0.f, 0.f, 0.f};
    bf16x8 At[4][2], B0[2][2], B1[2][2];
    const char* cA = (const char*)g.A + (size_t)cur.pm * tstepA + (size_t)(cur.pn >> 1) * g.agrp; const char* cB = (const char*)g.Bt + (size_t)cur.pn * tstepB;
    PG8_STAGE(PG8_SB(0, 0), cB, voffB); PG8_STAGE(PG8_SB(0, 1), cB + hstepB, voffB); PG8_STAGE(PG8_SA(0, 0), cA, voffA); PG8_STAGE(PG8_SA(0, 1), cA + hstepA, voffA);
    if (wr == 1) PG8_BAR;
    PG8_WAIT_V(2); PG8_BAR;
    PG8_STAGE(PG8_SB(1, 0), cB + kstep, voffB); PG8_STAGE(PG8_SA(1, 0), cA + kstep, voffA); PG8_STAGE(PG8_SB(1, 1), cB + hstepB + kstep, voffB);
    PG8_WAIT_V(6); PG8_BAR;
    for (;;) {
        const bool has_next = S.next(ui + 1, nxt);
        const char* nA = has_next ? (const char*)g.A + (size_t)nxt.pm * tstepA + (size_t)(nxt.pn >> 1) * g.agrp : cA; const char* nB = has_next ? (const char*)g.Bt + (size_t)nxt.pn * tstepB : cB;
        for (int t = 0; t < nt; t += 2) {
            const bool last = (t == nt - 2);
            const char* a1 = cA + (size_t)(t + 1) * kstep;
            const char* a2 = last ? nA : cA + (size_t)(t + 2) * kstep; const char* b2 = last ? nB : cB + (size_t)(t + 2) * kstep;
            const char* a3 = a2 + kstep; const char* b3 = b2 + kstep;
            PG8_LDB(B0, 0, 0); PG8_LDB(B1, 0, 1); PG8_SCHED; PG8_LDA(At, 0, 0); PG8_STAGE(PG8_SA(1, 1), a1 + hstepA, voffA);
            PG8_WAIT_V(8); PG8_WAIT_L(0); PG8_BAR; PG8_MMA(0, 0, At, B0); PG8_MMA(0, 1, At, B1); PG8_BAR; PG8_SCHED;
            PG8_LDA(At, 0, 1); PG8_STAGE(PG8_SB(0, 0), b2, voffB); PG8_STAGE(PG8_SB(0, 1), b2 + hstepB, voffB); PG8_STAGE(PG8_SA(0, 0), a2, voffA);
            PG8_WAIT_V(8); PG8_WAIT_L(0); PG8_BAR; PG8_MMA(1, 0, At, B0); PG8_MMA(1, 1, At, B1); PG8_BAR; PG8_SCHED;
            PG8_LDB(B0, 1, 0); PG8_LDB(B1, 1, 1); PG8_SCHED; PG8_LDA(At, 1, 0); PG8_STAGE(PG8_SA(0, 1), a2 + hstepA, voffA);
            PG8_WAIT_V(8); PG8_WAIT_L(0); PG8_BAR; PG8_MMA(0, 0, At, B0); PG8_MMA(0, 1, At, B1); PG8_BAR; PG8_SCHED;
            PG8_LDA(At, 1, 1); PG8_STAGE(PG8_SB(1, 0), b3, voffB); PG8_STAGE(PG8_SB(1, 1), b3 + hstepB, voffB); PG8_STAGE(PG8_SA(1, 0), a3, voffA);
            PG8_WAIT_V(8); PG8_WAIT_L(0); PG8_BAR; PG8_MMA(1, 0, At, B0); PG8_MMA(1, 1, At, B1); PG8_BAR; PG8_SCHED;
        }
        if constexpr (ALIGN_EPI) { if (wr == 0) PG8_BAR; }
        E(acc, cur, wr, wc, fr, fq);
        if (!has_next) break;
#pragma unroll
        for (int a = 0; a < 2; ++a)
#pragma unroll
            for (int b = 0; b < 2; ++b)
#pragma unroll
                for (int m = 0; m < 4; ++m)
#pragma unroll
                    for (int n = 0; n < 2; ++n) acc[a][b][m][n] = (f32x4){0.f, 0.f, 0.f, 0.f};
        cur = nxt; cA = nA; cB = nB; ++ui;
        if constexpr (ALIGN_EPI) { if (wr == 1) PG8_BAR; }
    }
    PG8_WAIT_V(0);
    if constexpr (!ALIGN_EPI) { if (wr == 0) PG8_BAR; }
    PG8_BAR;
#undef PG8_SA
#undef PG8_SB
#undef PG8_STAGE
#undef PG8_LDA
#undef PG8_LDB
#undef PG8_MMA
#undef PG8_WAIT_V
#undef PG8_WAIT_L
#undef PG8_BAR
#undef PG8_SCHED
}
}

struct Args { const float* in[21]; float* out; unsigned char* ws; };
enum { I_X = 0, I_MIXN, I_FFNN, I_WQKV, I_QG, I_KG, I_SINK, I_WO, I_WIN, I_RCW, I_RCB, I_WA, I_BA, I_WI, I_BI, I_LAM, I_WOUT, I_WUP, I_FCW, I_FCB, I_WDN };

__device__ __forceinline__ float wave_sum(float v) {
#pragma unroll
    for (int o = 1; o < 64; o <<= 1) v += __shfl_xor(v, o);
    return v;
}

struct TDesc { const float* W; const float* gain; bf16_t* O; int ldw, ldt; };
__device__ __forceinline__ void titem_load(const TDesc& d, f32x4 (&v)[16], f32x4 (&g)[4], int lane) {
    const int lr = lane >> 4, ln = lane & 15;
    const float* wp = d.W + (size_t)(4 * lr) * d.ldw + 4 * ln;
#pragma unroll
    for (int i = 0; i < 16; ++i) v[i] = *(const f32x4*)(wp + (size_t)(16 * (i >> 2) + (i & 3)) * d.ldw);
#pragma unroll
    for (int b = 0; b < 4; ++b) g[b] = d.gain ? *(const f32x4*)(d.gain + 16 * b + 4 * lr) : (f32x4){1.f, 1.f, 1.f, 1.f};
}
__device__ __forceinline__ void titem_store(const TDesc& d, const f32x4 (&v)[16], const f32x4 (&g)[4], LAS unsigned char* scr, int lane) {
    const int lr = lane >> 4, ln = lane & 15;
#pragma unroll
    for (int b = 0; b < 4; ++b)
#pragma unroll
        for (int e = 0; e < 4; ++e) {
            u32x2 w; w.x = cvt_pk_bf16(v[4 * b + 0][e] * g[b][0], v[4 * b + 1][e] * g[b][1]); w.y = cvt_pk_bf16(v[4 * b + 2][e] * g[b][2], v[4 * b + 3][e] * g[b][3]);
            *(LAS u32x2*)(scr + (4 * ln + e) * 136 + (16 * b + 4 * lr) * 2) = w; }
    asm volatile("s_waitcnt lgkmcnt(0)" ::: "memory");
    const int rn = lane >> 3, c = lane & 7;
#pragma unroll
    for (int j = 0; j < 8; ++j) { const int n = 8 * j + rn;
        const u32x2 lo = *(const LAS u32x2*)(scr + n * 136 + 16 * c), hi = *(const LAS u32x2*)(scr + n * 136 + 16 * c + 8);
        *(u32x4*)(d.O + (size_t)n * d.ldt + 8 * c) = (u32x4){lo.x, lo.y, hi.x, hi.y}; }
    asm volatile("s_waitcnt lgkmcnt(0)" ::: "memory");
}

struct Job { const float* W; const float* gain; bf16_t* WT; int ldw, ldt, K, N, gate_which; };
__device__ __forceinline__ Job get_job(const Args& a, int jb) {
    Job J; J.gain = nullptr; J.gate_which = -1; unsigned char* ws = a.ws;
    int kind, idx;
    if (jb < 8) { const int j = jb >> 2, l = 2 * j; kind = jb & 3; idx = (kind == 0 || kind == 3) ? j : l; }
    else { const int r = (jb - 8) % 20, j = (jb - 8) / 20, l = 2 * j + 1;
        if (r < 4) { kind = r == 0 ? 4 : r == 1 ? 5 : r == 2 ? 1 : 2; idx = (r < 2) ? j : l; } else { kind = 6; idx = j * 16 + (r - 4); } }
    if (kind == 0) { J.W = a.in[I_WQKV] + (size_t)idx * D * QKVD; J.gain = a.in[I_MIXN] + (size_t)(2 * idx) * D; J.WT = (bf16_t*)(ws + WS_WQKV) + (size_t)idx * QKVD * D; J.ldw = QKVD; J.ldt = D; J.K = D; J.N = QKVD; }
    else if (kind == 1) { J.W = a.in[I_WUP] + (size_t)idx * D * FF2; J.gain = a.in[I_FFNN] + (size_t)idx * D; J.WT = (bf16_t*)(ws + WS_WUP) + (size_t)idx * FF2 * D; J.ldw = FF2; J.ldt = D; J.K = D; J.N = FF2; J.gate_which = 2; }
    else if (kind == 2) { J.W = a.in[I_WDN] + (size_t)idx * FF * D; J.WT = (bf16_t*)(ws + WS_WDN) + (size_t)idx * D * FF; J.ldw = D; J.ldt = FF; J.K = FF; J.N = D; }
    else if (kind == 3) { J.W = a.in[I_WO] + (size_t)idx * D * D; J.WT = (bf16_t*)(ws + WS_WO) + (size_t)idx * D * D; J.ldw = D; J.ldt = D; J.K = D; J.N = D; }
    else if (kind == 4) { J.W = a.in[I_WIN] + (size_t)idx * D * 2 * D; J.gain = a.in[I_MIXN] + (size_t)(2 * idx + 1) * D; J.WT = (bf16_t*)(ws + WS_WIN) + (size_t)idx * 2 * D * D; J.ldw = 2 * D; J.ldt = D; J.K = D; J.N = 2 * D; }
    else if (kind == 5) { J.W = a.in[I_WOUT] + (size_t)idx * D * D; J.WT = (bf16_t*)(ws + WS_WOUT) + (size_t)idx * D * D; J.ldw = D; J.ldt = D; J.K = D; J.N = D; }
    else { const int j = idx >> 4, which = (idx >> 3) & 1, h = idx & 7;
      J.W = a.in[which ? I_WI : I_WA] + ((size_t)j * 8 + h) * 256 * 256; J.WT = (bf16_t*)(ws + WS_WG) + (size_t)j * 4096 * 256 + (size_t)h * 512 * 256;
      J.ldw = 256; J.ldt = 256; J.K = 256; J.N = 256; J.gate_which = which; }
    return J;
}

struct TIter {
    const Args* a; int jb, jb1, gw, NGW, base, it, nit, nN; Job J;
    __device__ __forceinline__ void open() { J = get_job(*a, jb); nN = J.N / 64; nit = (J.K / 64) * nN; int first = (gw - base) % NGW; if (first < 0) first += NGW; it = first; }
    __device__ __forceinline__ bool next(TDesc& d) {
        while (jb < jb1) {
            if (it < nit) {
                const int kb = it / nN, nb = it % nN, k0 = 64 * kb, n0 = 64 * nb; int orow0 = n0;
                if (J.gate_which == 2) { const int ch = n0 < FF ? n0 : n0 - FF; orow0 = 256 * (ch >> 7) + (n0 < FF ? 0 : 128) + (ch & 127); }
                else if (J.gate_which >= 0) orow0 = 256 * (n0 >> 7) + 128 * J.gate_which + (n0 & 127);
                d.W = J.W + (size_t)k0 * J.ldw + n0; d.gain = J.gain ? J.gain + k0 : nullptr; d.O = J.WT + (size_t)orow0 * J.ldt + k0; d.ldw = J.ldw; d.ldt = J.ldt;
                it += NGW; return true; }
            base = (base + nit) % NGW; ++jb; if (jb < jb1) open();
        }
        return false;
    }
};
__device__ __forceinline__ void convert_jobs(const Args& a, LAS unsigned char* lds, int jb0, int jb1, int worker_wg, int n_wg) {
    int tid = threadIdx.x; asm volatile("" : "+v"(tid));
    const int lane = tid & 63, wave = __builtin_amdgcn_readfirstlane(tid >> 6);
    LAS unsigned char* scr = lds + wave * 8704;
    TIter itr; itr.a = &a; itr.jb = jb0; itr.jb1 = jb1; itr.gw = worker_wg * 8 + wave; itr.NGW = n_wg * 8; itr.base = 0;
    if (jb0 >= jb1) return;
    itr.open();
    TDesc dA, dB; f32x4 vA[16], vB[16], gA[4], gB[4];
    bool hA = itr.next(dA); if (hA) titem_load(dA, vA, gA, lane);
    while (hA) {
        const bool hB = itr.next(dB); if (hB) titem_load(dB, vB, gB, lane);
        titem_store(dA, vA, gA, scr, lane);
        if (!hB) break;
        hA = itr.next(dA); if (hA) titem_load(dA, vA, gA, lane);
        titem_store(dB, vB, gB, scr, lane);
    }
}

__device__ __forceinline__ void prologue(const Args& a, LAS unsigned char* lds, int vcu, int G) {
    const int tid = threadIdx.x, lane = tid & 63, wave = __builtin_amdgcn_readfirstlane(tid >> 6);
    const int gw = vcu * 8 + wave, NGW = G * 8;
    {
        const float* x = a.in[I_X]; bf16_t* XB = (bf16_t*)(a.ws + WS_XB); unsigned long long* SSQ = (unsigned long long*)(a.ws + WS_SSQ);
        for (int m = gw; m < T; m += NGW) {
            const f32x4* xr = (const f32x4*)(x + (size_t)m * D) + lane; float s = 0.f;
            unsigned long long* o8 = (unsigned long long*)(XB + (size_t)m * D) + lane;
#pragma unroll
            for (int j = 0; j < 8; ++j) { const f32x4 v = xr[64 * j]; s += (v[0] * v[0] + v[1] * v[1]) + (v[2] * v[2] + v[3] * v[3]);
                o8[64 * j] = (unsigned long long)cvt_pk_bf16(v[0], v[1]) | ((unsigned long long)cvt_pk_bf16(v[2], v[3]) << 32); }
            s = wave_sum(s);
            if (lane < 8) SSQ[(size_t)lane * T + m] = lane == 0 ? (unsigned long long)(s * SSQ_SCALE) : 0ull;
        }
    }
    convert_jobs(a, lds, 0, DEFER_CONV ? 8 : 48, vcu, G);
}

__device__ __forceinline__ void ffn_fix_phase(const float* __restrict__ halo, const float* __restrict__ cw, const float* __restrict__ cb, bf16_t* __restrict__ ACT, int vcu, int G) {
    int tid = threadIdx.x; asm volatile("" : "+v"(tid)); const int gtid = vcu * 512 + tid, GT = G * 512;
    constexpr int NQ = FF / 4, NTASK = 32 * 2 * NQ;
    for (int task = gtid; task < NTASK; task += GT) {
        const int cq = task % NQ, r = (task / NQ) & 1, pm = task / (2 * NQ), c0 = cq * 4, tc = (c0 >> 7) * 256 + (c0 & 127);
        const f32x4 z = {0.f, 0.f, 0.f, 0.f};
        const float* h0 = halo + (size_t)(pm * 4) * FF2 + tc; const float* hp = halo + (size_t)(pm * 4 - 4) * FF2 + tc;
        const f32x4 g0 = *(const f32x4*)(h0 + (size_t)r * FF2), v0 = *(const f32x4*)(h0 + (size_t)r * FF2 + 128);
        f32x4 g1, v1, g2, v2;
        if (r == 1) { g1 = *(const f32x4*)(h0); v1 = *(const f32x4*)(h0 + 128); if (pm > 0) { g2 = *(const f32x4*)(hp + 3 * (size_t)FF2); v2 = *(const f32x4*)(hp + 3 * (size_t)FF2 + 128); } else { g2 = z; v2 = z; } }
        else if (pm > 0) { g1 = *(const f32x4*)(hp + 3 * (size_t)FF2); v1 = *(const f32x4*)(hp + 3 * (size_t)FF2 + 128); g2 = *(const f32x4*)(hp + 2 * (size_t)FF2); v2 = *(const f32x4*)(hp + 2 * (size_t)FF2 + 128); }
        else { g1 = z; v1 = z; g2 = z; v2 = z; }
        const f32x4 wg0 = *(const f32x4*)(cw + c0), wg1 = *(const f32x4*)(cw + FF2 + c0), wg2 = *(const f32x4*)(cw + 2 * FF2 + c0), bg = *(const f32x4*)(cb + c0);
        const f32x4 wv0 = *(const f32x4*)(cw + FF + c0), wv1 = *(const f32x4*)(cw + FF2 + FF + c0), wv2 = *(const f32x4*)(cw + 2 * FF2 + FF + c0), bv = *(const f32x4*)(cb + FF + c0);
        float o[4];
#pragma unroll
        for (int e = 0; e < 4; ++e) { const float ug = bg[e] + wg0[e] * g2[e] + wg1[e] * g1[e] + wg2[e] * g0[e], uv = bv[e] + wv0[e] * v2[e] + wv1[e] * v1[e] + wv2[e] * v0[e]; o[e] = gelu_tanh(ug) * uv; }
        *(u32x2*)(ACT + (size_t)(pm * 256 + r) * FF + c0) = (u32x2){cvt_pk_bf16(o[0], o[1]), cvt_pk_bf16(o[2], o[3])};
    }
}

__device__ __forceinline__ void rec_conv_phase(const bf16_t* __restrict__ REC, const float* __restrict__ cw, const float* __restrict__ cb, bf16_t* __restrict__ XC, int vcu, int G) {
    int tid = threadIdx.x; asm volatile("" : "+v"(tid)); const int gtid = vcu * 512 + tid, GT = G * 512;
    constexpr int NCG = D / 8, NTASK = (T / 16) * NCG;
    for (int task = gtid; task < NTASK; task += GT) {
        const int cgp = task % NCG, rc = task / NCG, c0 = cgp * 8, t0 = rc * 16;
        float w[4][8], b[8];
#pragma unroll
        for (int k = 0; k < 4; ++k) { const f32x4 a0 = *(const f32x4*)(cw + (size_t)k * D + c0), a1 = *(const f32x4*)(cw + (size_t)k * D + c0 + 4);
#pragma unroll
            for (int e = 0; e < 4; ++e) { w[k][e] = a0[e]; w[k][4 + e] = a1[e]; } }
        { const f32x4 a0 = *(const f32x4*)(cb + c0), a1 = *(const f32x4*)(cb + c0 + 4);
#pragma unroll
            for (int e = 0; e < 4; ++e) { b[e] = a0[e]; b[4 + e] = a1[e]; } }
        float x3[8], x2[8], x1[8];
#pragma unroll
        for (int e = 0; e < 8; ++e) { x3[e] = 0.f; x2[e] = 0.f; x1[e] = 0.f; }
        if (t0 > 0) {
            const u32x4 ra = *(const u32x4*)(REC + (size_t)(t0 - 3) * 2 * D + c0), rb = *(const u32x4*)(REC + (size_t)(t0 - 2) * 2 * D + c0), rc2 = *(const u32x4*)(REC + (size_t)(t0 - 1) * 2 * D + c0);
#pragma unroll
            for (int e = 0; e < 4; ++e) { x3[2 * e] = bflo(ra[e]); x3[2 * e + 1] = bfhi(ra[e]); x2[2 * e] = bflo(rb[e]); x2[2 * e + 1] = bfhi(rb[e]); x1[2 * e] = bflo(rc2[e]); x1[2 * e + 1] = bfhi(rc2[e]); }
        }
        u32x4 rrow[16];
#pragma unroll
        for (int r = 0; r < 16; ++r) rrow[r] = *(const u32x4*)(REC + (size_t)(t0 + r) * 2 * D + c0);
#pragma unroll
        for (int r = 0; r < 16; ++r) {
            const int t = t0 + r;
            const u32x4 rr = rrow[r];
            float x0[8], o[8];
#pragma unroll
            for (int e = 0; e < 4; ++e) { x0[2 * e] = bflo(rr[e]); x0[2 * e + 1] = bfhi(rr[e]); }
#pragma unroll
            for (int e = 0; e < 8; ++e) { o[e] = b[e] + w[0][e] * x3[e] + w[1][e] * x2[e] + w[2][e] * x1[e] + w[3][e] * x0[e]; x3[e] = x2[e]; x2[e] = x1[e]; x1[e] = x0[e]; }
            u32x4 wv; wv.x = cvt_pk_bf16(o[0], o[1]); wv.y = cvt_pk_bf16(o[2], o[3]); wv.z = cvt_pk_bf16(o[4], o[5]); wv.w = cvt_pk_bf16(o[6], o[7]);
            *(u32x4*)(XC + (size_t)t * D + c0) = wv;
        }
    }
}

__device__ __forceinline__ float bfe(const u32x4& v, int e) { const unsigned w = v[e >> 1]; return (e & 1) ? bfhi(w) : bflo(w); }
__device__ __forceinline__ void scan1_phase(const bf16_t* __restrict__ GP, const bf16_t* __restrict__ XC, const float* __restrict__ ba, const float* __restrict__ bi, const float* __restrict__ lam, bf16_t* __restrict__ LB, bf16_t* __restrict__ UB, float* __restrict__ E, float* __restrict__ AP, int blk, int G) {
    int tid = threadIdx.x; asm volatile("" : "+v"(tid));
    for (int unit = blk; unit < 256; unit += G) {
        const int sc = unit * 2 + (tid >> 8), ch = (tid & 255) * 8, gcol = (ch >> 7) * 256 + (ch & 127);
        float vba[8], vbi[8], vsp[8];
        { const f32x4 a0 = *(const f32x4*)(ba + ch), a1 = *(const f32x4*)(ba + ch + 4), b0 = *(const f32x4*)(bi + ch), b1 = *(const f32x4*)(bi + ch + 4), l0 = *(const f32x4*)(lam + ch), l1 = *(const f32x4*)(lam + ch + 4);
#pragma unroll
          for (int e = 0; e < 4; ++e) { vba[e] = a0[e]; vba[4 + e] = a1[e]; vbi[e] = b0[e]; vbi[4 + e] = b1[e]; vsp[e] = -8.0f * LOG2E * log1pf(__expf(-l0[e])); vsp[4 + e] = -8.0f * LOG2E * log1pf(__expf(-l1[e])); } }
        float h[8], pr[8];
#pragma unroll
        for (int e = 0; e < 8; ++e) { h[e] = 0.f; pr[e] = 1.f; }
        const bf16_t* gp = GP + (size_t)(sc * 16) * 4096 + gcol; const bf16_t* xc = XC + (size_t)(sc * 16) * D + ch;
        bf16_t* lb = LB + (size_t)(sc * 16) * D + ch; bf16_t* ub = UB + (size_t)(sc * 16) * D + ch;
#pragma unroll 1
        for (int r8 = 0; r8 < 16; r8 += 8) {
        u32x4 pav[8], piv[8], xvv[8];
#pragma unroll
        for (int i = 0; i < 8; ++i) { pav[i] = *(const u32x4*)(gp + (size_t)(r8 + i) * 4096); piv[i] = *(const u32x4*)(gp + (size_t)(r8 + i) * 4096 + 128); xvv[i] = *(const u32x4*)(xc + (size_t)(r8 + i) * D); }
#pragma unroll
        for (int i = 0; i < 8; ++i) {
            const int r = r8 + i;
            const u32x4 pa = pav[i], pi = piv[i], xv = xvv[i];
            float l[8];
#pragma unroll
            for (int e = 0; e < 8; ++e) l[e] = vsp[e] * sigmoidf_(bfe(pa, e) + vba[e]);
            const u32x4 lpk = {cvt_pk_bf16(l[0], l[1]), cvt_pk_bf16(l[2], l[3]), cvt_pk_bf16(l[4], l[5]), cvt_pk_bf16(l[6], l[7])};
            float a[8], u[8];
#pragma unroll
            for (int e = 0; e < 8; ++e) { a[e] = __builtin_amdgcn_exp2f(bfe(lpk, e)); u[e] = sqrtf(fmaxf(1.0f - a[e] * a[e], 0.f)) * sigmoidf_(bfe(pi, e) + vbi[e]) * bfe(xv, e); }
            const u32x4 upk = {cvt_pk_bf16(u[0], u[1]), cvt_pk_bf16(u[2], u[3]), cvt_pk_bf16(u[4], u[5]), cvt_pk_bf16(u[6], u[7])};
            *(u32x4*)(lb + (size_t)r * D) = lpk; *(u32x4*)(ub + (size_t)r * D) = upk;
#pragma unroll
            for (int e = 0; e < 8; ++e) { h[e] = a[e] * h[e] + bfe(upk, e); pr[e] *= a[e]; }
        }
        }
        float* eo = E + (size_t)sc * D + ch; float* po = AP + (size_t)sc * D + ch;
        *(f32x4*)(eo) = (f32x4){h[0], h[1], h[2], h[3]}; *(f32x4*)(eo + 4) = (f32x4){h[4], h[5], h[6], h[7]};
        *(f32x4*)(po) = (f32x4){pr[0], pr[1], pr[2], pr[3]}; *(f32x4*)(po + 4) = (f32x4){pr[4], pr[5], pr[6], pr[7]};
    }
}
__device__ __forceinline__ void scanc_phase(const float* __restrict__ E, const float* __restrict__ AP, float* __restrict__ CIN, LAS unsigned char* lds, int blk, int G) {
    int tid = threadIdx.x; asm volatile("" : "+v"(tid));
    LAS float* sP = (LAS float*)lds; LAS float* sE = sP + 512;
    const int k = tid & 7, g = tid >> 3;
    for (int unit = blk; unit < 256; unit += G) {
        const int ch = unit * 8 + k;
        float e[8], p[8];
#pragma unroll
        for (int i = 0; i < 8; ++i) { e[i] = E[(size_t)(g * 8 + i) * D + ch]; p[i] = AP[(size_t)(g * 8 + i) * D + ch]; }
        float Pg = 1.f, Eg = 0.f;
#pragma unroll
        for (int i = 0; i < 8; ++i) { Eg = p[i] * Eg + e[i]; Pg *= p[i]; }
        sP[tid] = Pg; sE[tid] = Eg;
        __syncthreads();
        if (tid < 8) { float hc = 0.f;
            for (int gg = 0; gg < 64; ++gg) { const float Pq = sP[gg * 8 + tid], Eq = sE[gg * 8 + tid]; sE[gg * 8 + tid] = hc; hc = Pq * hc + Eq; } }
        __syncthreads();
        float hc = sE[tid];
#pragma unroll
        for (int i = 0; i < 8; ++i) { CIN[(size_t)(g * 8 + i) * D + ch] = hc; hc = p[i] * hc + e[i]; }
        __syncthreads();
    }
}
__device__ __forceinline__ void scan2_phase(const bf16_t* __restrict__ LB, const bf16_t* __restrict__ UB, const float* __restrict__ CIN, const bf16_t* __restrict__ REC, bf16_t* __restrict__ HG, int blk, int G) {
    int tid = threadIdx.x; asm volatile("" : "+v"(tid));
    for (int unit = blk; unit < 256; unit += G) {
        const int sc = unit * 2 + (tid >> 8), ch = (tid & 255) * 8;
        float h[8];
        { const f32x4 c0 = *(const f32x4*)(CIN + (size_t)sc * D + ch), c1 = *(const f32x4*)(CIN + (size_t)sc * D + ch + 4);
#pragma unroll
          for (int e = 0; e < 4; ++e) { h[e] = c0[e]; h[4 + e] = c1[e]; } }
        const bf16_t* lb = LB + (size_t)(sc * 16) * D + ch; const bf16_t* ub = UB + (size_t)(sc * 16) * D + ch;
        const bf16_t* yb = REC + (size_t)(sc * 16) * 2 * D + D + ch; bf16_t* hg = HG + (size_t)(sc * 16) * D + ch;
#pragma unroll 1
        for (int r8 = 0; r8 < 16; r8 += 8) {
        u32x4 lv[8], uv8[8], yv[8];
#pragma unroll
        for (int i = 0; i < 8; ++i) { lv[i] = *(const u32x4*)(lb + (size_t)(r8 + i) * D); uv8[i] = *(const u32x4*)(ub + (size_t)(r8 + i) * D); yv[i] = *(const u32x4*)(yb + (size_t)(r8 + i) * 2 * D); }
#pragma unroll
        for (int i = 0; i < 8; ++i) {
            const int r = r8 + i;
            const u32x4 lpk = lv[i], upk = uv8[i], y = yv[i];
            float o[8];
#pragma unroll
            for (int e = 0; e < 8; ++e) h[e] = __builtin_amdgcn_exp2f(bfe(lpk, e)) * h[e] + bfe(upk, e);
#pragma unroll
            for (int e = 0; e < 4; ++e) { const f32x2 gy = gelu_tanh2((f32x2){bflo(y[e]), bfhi(y[e])}); o[2 * e] = h[2 * e] * gy.x; o[2 * e + 1] = h[2 * e + 1] * gy.y; }
            *(u32x4*)(hg + (size_t)r * D) = (u32x4){cvt_pk_bf16(o[0], o[1]), cvt_pk_bf16(o[2], o[3]), cvt_pk_bf16(o[4], o[5]), cvt_pk_bf16(o[6], o[7])};
        }
        }
    }
}

__device__ __forceinline__ int crow(int r, int hi) { return (r & 3) + 8 * (r >> 2) + 4 * hi; }
__device__ __forceinline__ void attn_phase(LAS unsigned char* lds, const bf16_t* __restrict__ QKV, bf16_t* __restrict__ AO, const float* __restrict__ qg, const float* __restrict__ kg, const float* __restrict__ sinks, int vcu, int G) {
    int tid = threadIdx.x; asm volatile("" : "+v"(tid));
    const int lane = tid & 63, wid = __builtin_amdgcn_readfirstlane(tid >> 6), r32 = lane & 31, hi = lane >> 5;
    constexpr int KS_STRIDE = 144, VT_STRIDE = 528, VT_OFF = 256 * KS_STRIDE;
    LAS unsigned char* Ks = lds; LAS unsigned char* VT = lds + VT_OFF;
    u32x4 rk[4], rv[4];
#define ATT_LOAD_KV(UNIT) do { const int qb_ = (UNIT) >> 3, kvh_ = (UNIT) & 7; _Pragma("unroll") for (int i = 0; i < 4; ++i) { const int id = tid + 512 * i, w = id >> 3, c = id & 7; int grow = 128 * (qb_ - 1) + w; if (grow < 0) grow = 0; \
        const bf16_t* rowp = QKV + (size_t)grow * QKVD; rk[i] = *(const u32x4*)(rowp + D + kvh_ * 64 + c * 8); rv[i] = *(const u32x4*)(rowp + D + 512 + kvh_ * 64 + c * 8); } } while (0)
    if (vcu < 512) ATT_LOAD_KV(vcu);
    for (int unit = vcu; unit < 512; unit += G) {
        const int qb = unit >> 3, kvh = unit & 7;
        u32x4 qraw[2][4];
#pragma unroll
        for (int st = 0; st < 2; ++st)
#pragma unroll
            for (int d0 = 0; d0 < 4; ++d0) qraw[st][d0] = *(const u32x4*)(QKV + (size_t)(128 * qb + 64 * (wid & 1) + 32 * st + r32) * QKVD + (kvh * 4 + (wid >> 1)) * 64 + d0 * 16 + hi * 8);
#pragma unroll
        for (int i = 0; i < 4; ++i) {
            const int id = tid + 512 * i, w = id >> 3, c = id & 7;
            const u32x4 kr = rk[i], vr = rv[i];
            float kf[8] = {bflo(kr.x), bfhi(kr.x), bflo(kr.y), bfhi(kr.y), bflo(kr.z), bfhi(kr.z), bflo(kr.w), bfhi(kr.w)};
            float ss = 0.f;
#pragma unroll
            for (int e = 0; e < 8; ++e) ss += kf[e] * kf[e];
            ss += __shfl_xor(ss, 1); ss += __shfl_xor(ss, 2); ss += __shfl_xor(ss, 4);
            const float rs = rsqrtf(ss * (1.0f / 64.0f) + EPS);
            const f32x4 g0 = *(const f32x4*)(kg + c * 8), g1 = *(const f32x4*)(kg + c * 8 + 4);
            u32x4 ko; ko.x = cvt_pk_bf16(kf[0] * rs * g0[0], kf[1] * rs * g0[1]); ko.y = cvt_pk_bf16(kf[2] * rs * g0[2], kf[3] * rs * g0[3]);
            ko.z = cvt_pk_bf16(kf[4] * rs * g1[0], kf[5] * rs * g1[1]); ko.w = cvt_pk_bf16(kf[6] * rs * g1[2], kf[7] * rs * g1[3]);
            *(LAS u32x4*)(Ks + w * KS_STRIDE + c * 16) = ko;
            const int pos = (w & ~15) + 8 * ((w >> 2) & 1) + (w & 3) + 4 * ((w >> 3) & 1);
            LAS bf16_t* vt = (LAS bf16_t*)(VT + (c * 8) * VT_STRIDE + pos * 2);
            vt[0 * (VT_STRIDE / 2)] = (bf16_t)(vr.x & 0xffff); vt[1 * (VT_STRIDE / 2)] = (bf16_t)(vr.x >> 16);
            vt[2 * (VT_STRIDE / 2)] = (bf16_t)(vr.y & 0xffff); vt[3 * (VT_STRIDE / 2)] = (bf16_t)(vr.y >> 16);
            vt[4 * (VT_STRIDE / 2)] = (bf16_t)(vr.z & 0xffff); vt[5 * (VT_STRIDE / 2)] = (bf16_t)(vr.z >> 16);
            vt[6 * (VT_STRIDE / 2)] = (bf16_t)(vr.w & 0xffff); vt[7 * (VT_STRIDE / 2)] = (bf16_t)(vr.w >> 16);
        }
        if (unit + G < 512) ATT_LOAD_KV(unit + G);
        __syncthreads();
        const int head = kvh * 4 + (wid >> 1);
        const float sink2 = sinks[head] * LOG2E;
#pragma unroll
        for (int st = 0; st < 2; ++st) {
            const int o32 = 64 * (wid & 1) + 32 * st;
            const size_t qrow = (size_t)(128 * qb + o32 + r32);
            bf16x8 qr[4];
            {
                float qf[4][8]; float ss = 0.f;
#pragma unroll
                for (int d0 = 0; d0 < 4; ++d0) { const u32x4 q = qraw[st][d0];
                    qf[d0][0] = bflo(q.x); qf[d0][1] = bfhi(q.x); qf[d0][2] = bflo(q.y); qf[d0][3] = bfhi(q.y); qf[d0][4] = bflo(q.z); qf[d0][5] = bfhi(q.z); qf[d0][6] = bflo(q.w); qf[d0][7] = bfhi(q.w);
#pragma unroll
                    for (int e = 0; e < 8; ++e) ss += qf[d0][e] * qf[d0][e]; }
                ss += __shfl_xor(ss, 32);
                const float rs = rsqrtf(ss * (1.0f / 64.0f) + EPS) * (0.125f * LOG2E);
#pragma unroll
                for (int d0 = 0; d0 < 4; ++d0) { const f32x4 g0 = *(const f32x4*)(qg + d0 * 16 + hi * 8), g1 = *(const f32x4*)(qg + d0 * 16 + hi * 8 + 4);
                    u32x4 w; w.x = cvt_pk_bf16(qf[d0][0] * rs * g0[0], qf[d0][1] * rs * g0[1]); w.y = cvt_pk_bf16(qf[d0][2] * rs * g0[2], qf[d0][3] * rs * g0[3]);
                    w.z = cvt_pk_bf16(qf[d0][4] * rs * g1[0], qf[d0][5] * rs * g1[1]); w.w = cvt_pk_bf16(qf[d0][6] * rs * g1[2], qf[d0][7] * rs * g1[3]);
                    qr[d0] = __builtin_bit_cast(bf16x8, w); }
            }
            f32x16 p[5];
#pragma unroll
            for (int t = 0; t < 5; ++t) {
                const int kbase = o32 + 32 * t;
                f32x16 accp = {};
#pragma unroll
                for (int d0 = 0; d0 < 4; ++d0) { const bf16x8 kf = *(const LAS bf16x8*)(Ks + (kbase + r32) * KS_STRIDE + d0 * 32 + hi * 16);
                    accp = __builtin_amdgcn_mfma_f32_32x32x16_bf16(kf, qr[d0], accp, 0, 0, 0); }
                p[t] = accp;
            }
            float mx = sink2;
#pragma unroll
            for (int t = 0; t < 5; ++t)
#pragma unroll
                for (int r = 0; r < 16; ++r) { const int w = o32 + 32 * t + crow(r, hi), rel = 128 + o32 + r32 - w;
                    const bool valid = (rel >= 0) && (rel < 128) && (qb > 0 || w >= 128);
                    const float v = valid ? p[t][r] : -INFINITY; p[t][r] = v; mx = fmaxf(mx, v); }
            mx = fmaxf(mx, __shfl_xor(mx, 32));
            float l = 0.f;
#pragma unroll
            for (int t = 0; t < 5; ++t)
#pragma unroll
                for (int r = 0; r < 16; ++r) { const float e = __builtin_amdgcn_exp2f(p[t][r] - mx); p[t][r] = e; l += e; }
            l += __shfl_xor(l, 32);
            l += __builtin_amdgcn_exp2f(sink2 - mx);
            const float inv = 1.0f / l;
            f32x16 o0 = {}, o1 = {};
#pragma unroll
            for (int t = 0; t < 5; ++t)
#pragma unroll
                for (int s = 0; s < 2; ++s) {
                    u32x4 pw; pw.x = cvt_pk_bf16(p[t][8 * s + 0], p[t][8 * s + 1]); pw.y = cvt_pk_bf16(p[t][8 * s + 2], p[t][8 * s + 3]); pw.z = cvt_pk_bf16(p[t][8 * s + 4], p[t][8 * s + 5]); pw.w = cvt_pk_bf16(p[t][8 * s + 6], p[t][8 * s + 7]);
                    const bf16x8 pb = __builtin_bit_cast(bf16x8, pw);
                    const int g16 = (o32 + 32 * t) / 16 + s;
                    const bf16x8 vf0 = *(const LAS bf16x8*)(VT + (r32) * VT_STRIDE + g16 * 32 + hi * 16);
                    const bf16x8 vf1 = *(const LAS bf16x8*)(VT + (32 + r32) * VT_STRIDE + g16 * 32 + hi * 16);
                    o0 = __builtin_amdgcn_mfma_f32_32x32x16_bf16(vf0, pb, o0, 0, 0, 0);
                    o1 = __builtin_amdgcn_mfma_f32_32x32x16_bf16(vf1, pb, o1, 0, 0, 0);
                }
            bf16_t* orow = AO + qrow * D + head * 64;
#pragma unroll
            for (int rg = 0; rg < 4; ++rg) {
                u32x2 w0, w1;
                w0.x = cvt_pk_bf16(o0[4 * rg + 0] * inv, o0[4 * rg + 1] * inv); w0.y = cvt_pk_bf16(o0[4 * rg + 2] * inv, o0[4 * rg + 3] * inv);
                w1.x = cvt_pk_bf16(o1[4 * rg + 0] * inv, o1[4 * rg + 1] * inv); w1.y = cvt_pk_bf16(o1[4 * rg + 2] * inv, o1[4 * rg + 3] * inv);
                *(u32x2*)(orow + 8 * rg + 4 * hi) = w0; *(u32x2*)(orow + 32 + 8 * rg + 4 * hi) = w1;
            }
        }
        __syncthreads();
    }
}


__device__ __forceinline__ void touch_phase(const u32x4* wp, int nchunk, unsigned* sink, int vcu, int G) {
    int tid = threadIdx.x; asm volatile("" : "+v"(tid));
    unsigned accx = 0u;
#pragma unroll 4
    for (int c = vcu * 512 + tid; c < nchunk; c += G * 512) { const u32x4 t = wp[c]; accx ^= t.x ^ t.y ^ t.z ^ t.w; }
    if (accx == 0x9e3779b9u && nchunk < 0) *sink = accx;
}

#define GAS __attribute__((address_space(1)))
#define XB_TMO      128
#define XB_XCNT(j)  (256  + 64 * (j))
#define XB_XSUB(j)  (1280 + 64 * (j))
#define XB_XGEN(j)  (2304 + 64 * (j))
#define XB_TOP      3328
#define XB_TOPGEN   3392
#define XCD_BAR_WORDS 3456
#define XB_SPIN_CAP (1u << 18)

__device__ __forceinline__ unsigned xb_ld(unsigned* p)              { return __hip_atomic_load(p, __ATOMIC_RELAXED, __HIP_MEMORY_SCOPE_AGENT); }
__device__ __forceinline__ unsigned xb_add(unsigned* p, unsigned v) { return __hip_atomic_fetch_add(p, v, __ATOMIC_RELAXED, __HIP_MEMORY_SCOPE_AGENT); }
__device__ __forceinline__ unsigned xb_xcc_id() { return (unsigned)__builtin_amdgcn_s_getreg((3 << 11) | 20) & 0xFu; }
#define XB_SPIN(cond, bar) do { unsigned _sp = 0; while (cond) { __builtin_amdgcn_s_sleep(1); \
    if ((++_sp & 255u) == 0u) { if (xb_ld(&(bar)[XB_TMO])) break; if (_sp > XB_SPIN_CAP) { atomicAdd(&(bar)[XB_TMO], 1u); break; } } } } while (0)

struct XcdBarrier {
    unsigned* bar; unsigned x;
    volatile LAS unsigned* st;
};

__device__ __forceinline__ XcdBarrier xcd_barrier_post(unsigned* bar, volatile LAS unsigned* st) {
    XcdBarrier b; b.bar = bar; b.x = xb_xcc_id(); b.st = st;
    if (threadIdx.x == 0) (void)xb_add(&bar[XB_XCNT(b.x)], 1u);
    return b;
}
__device__ __forceinline__ void xcd_barrier_complete(unsigned* bar, unsigned x, unsigned& nloc, unsigned& nx) {
    const unsigned G = gridDim.x * gridDim.y * gridDim.z;
    unsigned sum, cnt, mine, sp = 0u;
    for (;;) {
        sum = 0u; cnt = 0u; mine = 0u;
#pragma unroll
        for (unsigned j = 0; j < 16; ++j) { const unsigned c = xb_ld(&bar[XB_XCNT(j)]); sum += c; cnt += (c > 0u) ? 1u : 0u; mine = (j == x) ? c : mine; }
        if (sum == G) break;
        __builtin_amdgcn_s_sleep(1);
        if ((++sp & 255u) == 0u) { if (xb_ld(&bar[XB_TMO])) break; if (sp > XB_SPIN_CAP) { atomicAdd(&bar[XB_TMO], 1u); break; } }
    }
    nloc = mine > 0u ? mine : 1u; nx = cnt > 0u ? cnt : 1u;
}

__device__ __forceinline__ void xcd_barrier(const XcdBarrier& b) {
    asm volatile("s_waitcnt vmcnt(0)" ::: "memory");
    __syncthreads();
    if (threadIdx.x == 0) {
        unsigned* bar = b.bar;
        __builtin_amdgcn_s_waitcnt(0);
        unsigned nloc = b.st[0], nx = b.st[1];
        if (nloc == 0u) { xcd_barrier_complete(bar, b.x, nloc, nx); b.st[0] = nloc; b.st[1] = nx; }
        const unsigned old = xb_add(&bar[XB_XSUB(b.x)], 1u);
        const unsigned gen = old / nloc;
        if (old + 1u == (gen + 1u) * nloc) {
            __builtin_amdgcn_fence(__ATOMIC_RELEASE, "agent");
            asm volatile("s_waitcnt vmcnt(0)" ::: "memory");
            const unsigned og = xb_add(&bar[XB_TOP], 1u);
            const unsigned tg = og / nx;
            if (og + 1u == (tg + 1u) * nx) xb_add(&bar[XB_TOPGEN], 1u);
            else XB_SPIN(xb_ld(&bar[XB_TOPGEN]) == tg, bar);
            __builtin_amdgcn_fence(__ATOMIC_ACQUIRE, "agent");
            xb_add(&bar[XB_XGEN(b.x)], 1u);
            asm volatile("s_waitcnt vmcnt(0)" ::: "memory");
        } else {
            XB_SPIN(xb_ld(&bar[XB_XGEN(b.x)]) == gen, bar);
            __builtin_amdgcn_fence(__ATOMIC_ACQUIRE, "agent");
            asm volatile("s_waitcnt vmcnt(0)" ::: "memory");
        }
    }
    __syncthreads();
}
__global__ void __launch_bounds__(512, 2) fwd_megakernel(Args a) {
    extern __shared__ __attribute__((aligned(16))) unsigned char lds_raw[];
    LAS unsigned char* lds = (LAS unsigned char*)lds_raw;
    cg::grid_group grid = cg::this_grid();
    const int G = gridDim.x, bx = blockIdx.x;
    const int vcu = (G % 8 == 0) ? (bx % 8) * (G / 8) + bx / 8 : bx;

    volatile LAS unsigned* MISC = (volatile LAS unsigned*)(lds + MISC_OFF);
    if (threadIdx.x < 16) MISC[threadIdx.x] = 0u;
    unsigned* barw = (unsigned*)(a.ws + WS_BAR);
    if (bx == 0) for (int i = threadIdx.x; i < XCD_BAR_WORDS; i += 512) barw[i] = 0u;
    __syncthreads();
    prologue(a, lds, vcu, G);
    grid.sync();
    const XcdBarrier xbar = xcd_barrier_post(barw, MISC + 8);

#pragma unroll 1
    for (int step = 0; step < NSTEPS; ++step) {
        int layer, idx;
        if (step < 6) { layer = 0; idx = step; } else if (step < 16) { layer = 1; idx = step - 6; } else if (step < 22) { layer = 2; idx = step - 16; } else { layer = 3; idx = step - 22; }
        int kind = idx;
        if (layer & 1) kind = idx < 4 ? 6 + idx : (idx == 4 ? 12 : (idx < 7 ? 5 + idx : idx - 4));
        const int j = layer >> 1;
        unsigned char* ws = a.ws;
        unsigned long long* SSQ = (unsigned long long*)(ws + WS_SSQ);
        bf16_t* XB = (bf16_t*)(ws + WS_XB); bf16_t* QKV = (bf16_t*)(ws + WS_QKV); bf16_t* AO = (bf16_t*)(ws + WS_AO); bf16_t* REC = (bf16_t*)(ws + WS_REC); bf16_t* XC = (bf16_t*)(ws + WS_XC);
        bf16_t* GP = (bf16_t*)(ws + WS_GA); bf16_t* HG = (bf16_t*)(ws + WS_HG); bf16_t* P = (bf16_t*)(ws + WS_P); bf16_t* ACT = (bf16_t*)(ws + WS_ACT);
        float* CE = (float*)(ws + WS_CARRY); float* CAP = CE + 512 * D; float* CIN = CAP + 512 * D; bf16_t* LB = (bf16_t*)(ws + WS_GU); bf16_t* UB = LB + (size_t)T * D;
        if (kind == 3) {
            pg8::Gemm g; g.M = T; g.lda = D; g.ldb = D; g.K = D; g.agrp = 0; g.A = XB; g.Bt = (const bf16_t*)(ws + WS_WUP) + (size_t)layer * FF2 * D; g.N = FF2;
            pg8::EpiConvActP E; E.ACT = ACT; E.ssq = SSQ + (size_t)(2 * layer + 1) * T; E.cw = a.in[I_FCW] + (size_t)layer * 3 * FF2; E.cb = a.in[I_FCB] + (size_t)layer * FF2; E.halo = (float*)P; E.hl = lds + 131072;
            pg8::StaticOrder S; S.init(T, FF2, G, bx);
            pg8::gemm_phase<pg8::EpiConvActP, true, true>(lds, g, S, E);
        } else if (kind == 0 || kind == 6 || kind == 8) {
            pg8::Gemm g; pg8::EpiScaleBf16 E; g.M = T; g.lda = D; g.ldb = D; g.K = D; g.agrp = 0; g.A = XB;
            if (kind == 0)      { g.Bt = (const bf16_t*)(ws + WS_WQKV) + (size_t)j * QKVD * D; g.N = QKVD; E.O = QKV; E.ldc = QKVD; E.ssq = SSQ + (size_t)(2 * layer) * T; }
            else if (kind == 6) { g.Bt = (const bf16_t*)(ws + WS_WIN) + (size_t)j * 2 * D * D; g.N = 2 * D; E.O = REC; E.ldc = 2 * D; E.ssq = SSQ + (size_t)(2 * layer) * T; }
            else                { g.A = XC; g.Bt = (const bf16_t*)(ws + WS_WG) + (size_t)j * 4096 * 256; g.N = 4096; g.K = 256; g.ldb = 256; g.agrp = 512; E.O = GP; E.ldc = 4096; E.ssq = nullptr; }
            pg8::StaticOrder S; S.init(T, g.N, G, bx);
            pg8::gemm_phase<pg8::EpiScaleBf16, true>(lds, g, S, E);
            if (DEFER_CONV && kind == 0) {
                const int first_idle = 384 - G, jb0 = layer == 0 ? 8 : 28;
                if (first_idle > 0 && first_idle < G) { if (bx >= first_idle) convert_jobs(a, lds, jb0, jb0 + 20, bx - first_idle, G - first_idle); }
                else convert_jobs(a, lds, jb0, jb0 + 20, bx, G);
            }
        } else if (kind == 2 || kind == 5 || kind == 11) {
            pg8::Gemm g; pg8::EpiResid E; g.M = T; g.N = D; g.lda = D; g.ldb = D; g.K = D; g.agrp = 0;
            E.xold_f32 = nullptr; E.xnew_f32 = nullptr; E.xb = XB; E.ssq = SSQ + (size_t)(2 * layer + 1) * T;
            if (kind == 2)      { g.A = AO; g.Bt = (const bf16_t*)(ws + WS_WO) + (size_t)j * D * D; if (layer == 0) E.xold_f32 = a.in[I_X]; }
            else if (kind == 11){ g.A = HG; g.Bt = (const bf16_t*)(ws + WS_WOUT) + (size_t)j * D * D; }
            else                { g.A = ACT; g.Bt = (const bf16_t*)(ws + WS_WDN) + (size_t)layer * D * FF; g.K = FF; g.lda = FF; g.ldb = FF; E.ssq = layer < 3 ? SSQ + (size_t)(2 * layer + 2) * T : nullptr; if (layer == 3) E.xnew_f32 = a.out; }
            pg8::StaticOrder S; S.init(T, D, G, bx);
            pg8::gemm_phase<pg8::EpiResid, true>(lds, g, S, E);
        } else if (kind == 1) {
            attn_phase(lds, QKV, AO, a.in[I_QG] + j * 64, a.in[I_KG] + j * 64, a.in[I_SINK] + j * 32, vcu, G);
        } else if (kind == 4) {
            ffn_fix_phase((const float*)P, a.in[I_FCW] + (size_t)layer * 3 * FF2, a.in[I_FCB] + (size_t)layer * FF2, ACT, vcu, G);
            touch_phase((const u32x4*)((const bf16_t*)(ws + WS_WDN) + (size_t)layer * D * FF), D * FF * 2 / 16, (unsigned*)(ws + WS_BAR + 65536), vcu, G);
        } else if (kind == 7) {
            rec_conv_phase(REC, a.in[I_RCW] + (size_t)j * 4 * D, a.in[I_RCB] + (size_t)j * D, XC, vcu, G);
        } else if (kind == 9) {
            scan1_phase(GP, XC, a.in[I_BA] + (size_t)j * D, a.in[I_BI] + (size_t)j * D, a.in[I_LAM] + (size_t)j * D, LB, UB, CE, CAP, vcu, G);
        } else if (kind == 12) {
            scanc_phase(CE, CAP, CIN, lds, vcu, G);
        } else {
            scan2_phase(LB, UB, CIN, REC, HG, vcu, G);
        }
        if (step < NSTEPS - 1) xcd_barrier(xbar);
    }
}

extern "C" void kernel_launch(void* const* d_in, const int* in_sizes, int n_in, void* d_out, int out_size, void* d_ws, size_t ws_size, hipStream_t stream) {
    static int grid = 0;
    if (grid == 0) {
        if (n_in != 21 || out_size != T * D || ws_size < WS_END) { fprintf(stderr, "kernel_launch: unexpected problem (n_in %d out %d ws %zu)\n", n_in, out_size, ws_size); grid = -1; return; }
        int dev = 0, cus = 0, per_cu = 0;
        hipGetDevice(&dev); hipDeviceGetAttribute(&cus, hipDeviceAttributeMultiprocessorCount, dev);
        if (hipFuncSetAttribute((const void*)fwd_megakernel, hipFuncAttributeMaxDynamicSharedMemorySize, LDS_BYTES) != hipSuccess) { fprintf(stderr, "kernel_launch: hipFuncSetAttribute failed\n"); grid = -1; return; }
        if (hipOccupancyMaxActiveBlocksPerMultiprocessor(&per_cu, (const void*)fwd_megakernel, 512, LDS_BYTES) != hipSuccess || per_cu < 1) { fprintf(stderr, "kernel_launch: occupancy query says %d\n", per_cu); per_cu = 1; }
        (void)hipGetLastError();
        grid = cus * 1;
    }
    if (grid < 0) return;
    Args a{};
    for (int i = 0; i < 21; ++i) a.in[i] = (const float*)d_in[i];
    a.out = (float*)d_out; a.ws = (unsigned char*)d_ws;
    void* args[] = {&a};
    hipError_t e = hipLaunchCooperativeKernel((const void*)fwd_megakernel, dim3(grid), dim3(512), args, LDS_BYTES, stream);
    if (e != hipSuccess) fprintf(stderr, "cooperative launch failed: %s (grid %d)\n", hipGetErrorString(e), grid);
}
```
